# Optimizing an MI355X kernel written in HIP

```python
import jax
import jax.numpy as jnp
from jax import lax
import numpy as np

D_MODEL = 1024
BATCH = 4
SEQ = 4096
DEPTH = 2

CTX_LEN = 256
GRID_W = 64
F32 = jnp.float32

MLSTM_H = 4
MLSTM_DH = 64
MLSTM_W = MLSTM_H * MLSTM_DH
MLSTM_CHUNK = 64
CONV_W = 3
RWKV_H = 4
RWKV_N = 64
RWKV_W = RWKV_H * RWKV_N
DECAY_LORA = 64
AAA_LORA = 64
GATE_LORA = 128
RWKV_GN_EPS = 64e-5
MLA_H = 8
MLA_NOPE = 64
MLA_ROPE = 32
MLA_V = 64
MLA_W = MLA_H * MLA_V
Q_RANK = 256
KV_RANK = 128
ROPE_THETA = 10000.0
Q_BLOCK = 128
D_MIX = MLSTM_W + RWKV_W + MLA_W
MLSTM_COLS = (2 * MLSTM_W, MLSTM_W, MLSTM_W, 4 * MLSTM_H)
RWKV_COLS = (RWKV_W, RWKV_W, RWKV_W, 2 * DECAY_LORA, 2 * AAA_LORA, GATE_LORA)
MLA_COLS = (Q_RANK, KV_RANK, MLA_ROPE)
N_MLSTM_IN = 4 * MLSTM_W + 4 * MLSTM_H
N_RWKV_IN = 3 * RWKV_W + 2 * DECAY_LORA + 2 * AAA_LORA + GATE_LORA
N_MLA_IN = Q_RANK + KV_RANK + MLA_ROPE
N_IN = N_MLSTM_IN + N_RWKV_IN + N_MLA_IN
N_EXPERTS = 64
TOP_K = 8
N_GROUPS = 8
TOPK_GROUPS = 4
D_EXPERT = 256
ROUTED_SCALE = 2.5
MOE_BLOCK = 256
DEEPNORM_ALPHA = (2 * DEPTH) ** 0.25
DEEPNORM_BETA = (8 * DEPTH) ** -0.25
LN_EPS = 1e-6

kernel_name = 'hybrid_mlstm_rwkv7_mla_moe_dit_block'


def _split(z, sizes):
    return jnp.split(z, np.cumsum(sizes)[:-1].tolist(), axis=-1)


def _ln(x):
    xf = x.astype(F32)
    xc = xf - xf.mean(-1, keepdims=True)
    return xc * lax.rsqrt(jnp.mean(xc * xc, -1, keepdims=True) + LN_EPS)


def _modulate(x, shift, scale):
    return (_ln(x) * (1.0 + scale) + shift).astype(x.dtype)


def _post_norm(x_res, y, gate, w, b):
    return (_ln(DEEPNORM_ALPHA * x_res + gate * y) * w + b).astype(x_res.dtype)


def _rms(x, w):
    xf = x.astype(F32)
    return (xf * lax.rsqrt(jnp.mean(xf * xf, -1, keepdims=True) + 1e-6) * w).astype(x.dtype)


def _head_normalize(x, eps):
    xf = x.astype(F32)
    xc = xf - xf.mean(-1, keepdims=True)
    return xc * lax.rsqrt(jnp.mean(xc * xc, -1, keepdims=True) + eps)


def _centred_conv(z, w):
    t = z.shape[1]
    zp = jnp.pad(z, ((0, 0), (CONV_W // 2, CONV_W // 2), (0, 0)))
    return sum(w[j] * zp[:, j:j + t] for j in range(CONV_W))


def _bidir_token_shift(z, mu):
    zp = jnp.pad(z, ((0, 0), (1, 1), (0, 0)))
    return z + mu * (0.5 * (zp[:, :-2] + zp[:, 2:]) - z)


def _rope_tables(n):
    ROWS = n // GRID_W
    row = jnp.repeat(jnp.arange(ROWS), GRID_W).astype(F32)
    col = jnp.tile(jnp.arange(GRID_W), ROWS).astype(F32)
    n_freq = MLA_ROPE // 4
    freq = ROPE_THETA ** (-jnp.arange(n_freq, dtype=F32) / n_freq)
    ang = jnp.concatenate([row[:, None] * freq, col[:, None] * freq], -1)
    return jnp.cos(ang), jnp.sin(ang)


def _rope(x, cos, sin):
    xf = x.astype(F32).reshape(x.shape[:-1] + (-1, 2))
    x0, x1 = xf[..., 0], xf[..., 1]
    out = jnp.stack([x0 * cos - x1 * sin, x0 * sin + x1 * cos], -1)
    return out.reshape(x.shape).astype(x.dtype)


def _mlstm_chunked(q, k, v, log_i, log_f, state, emit):
    b2, h, t, dh = q.shape
    cl = MLSTM_CHUNK
    nc = t // cl
    q, k, v = (a.reshape(b2, h, nc, cl, dh) for a in (q, k, v))
    li = log_i.reshape(b2, h, nc, cl)
    bcum = jnp.cumsum(log_f.reshape(b2, h, nc, cl), axis=-1)
    b_end = bcum[..., -1]
    w_end = b_end[..., None] - bcum + li
    m_loc = w_end.max(-1)
    e_end = jnp.exp(w_end - m_loc[..., None])
    c_loc = jnp.einsum('bhcl,bhclv,bhclk->bhcvk', e_end, v, k)
    n_loc = jnp.einsum('bhcl,bhclk->bhck', e_end, k)

    def step(carry, xs):
        c_st, n_st, m_st = carry
        c_l, n_l, m_l, b_l = xs
        m_new = jnp.maximum(b_l + m_st, m_l)
        a_old = jnp.exp(b_l + m_st - m_new)
        a_loc = jnp.exp(m_l - m_new)
        c_new = a_old[..., None, None] * c_st + a_loc[..., None, None] * c_l
        n_new = a_old[..., None] * n_st + a_loc[..., None] * n_l
        return (c_new, n_new, m_new), (c_st, n_st, m_st)

    xs = tuple(jnp.moveaxis(a, 2, 0) for a in (c_loc, n_loc, m_loc, b_end))
    final, prev = lax.scan(step, state, xs)
    if not emit:
        return None, final
    c_prev, n_prev, m_prev = (jnp.moveaxis(a, 0, 2) for a in prev)
    lower = jnp.tril(jnp.ones((cl, cl), dtype=bool))
    d_log = jnp.where(lower, bcum[..., :, None] - bcum[..., None, :] + li[..., None, :], -jnp.inf)
    g_log = bcum + m_prev[..., None]
    m_row = jnp.maximum(g_log, d_log.max(-1))
    w_intra = jnp.exp(d_log - m_row[..., None]) * jnp.einsum('bhcjd,bhcsd->bhcjs', q, k)
    e_inter = jnp.exp(g_log - m_row)
    num = (jnp.einsum('bhcjs,bhcsv->bhcjv', w_intra, v)
           + e_inter[..., None] * jnp.einsum('bhcvk,bhcjk->bhcjv', c_prev, q))
    den = w_intra.sum(-1) + e_inter * jnp.einsum('bhck,bhcjk->bhcj', n_prev, q)
    out = num / jnp.maximum(jnp.abs(den), jnp.exp(-m_row))[..., None]
    return out.reshape(b2, h, t, dh), final


def _mlstm_prepare(z, conv_w, gate_bias):
    b, t, _ = z.shape
    zqk, zv, zo, zg = _split(z, MLSTM_COLS)
    zq, zk = jnp.split(jax.nn.silu(_centred_conv(zqk, conv_w)), 2, axis=-1)
    heads = lambda a: a.astype(F32).reshape(b, t, MLSTM_H, MLSTM_DH).transpose(0, 2, 1, 3)
    q = heads(zq) * MLSTM_DH ** -0.5
    k = heads(zk)
    v = heads(zv)
    g = (zg.astype(F32).reshape(b, t, 4, MLSTM_H) + gate_bias).transpose(2, 0, 3, 1)
    log_i = jnp.concatenate([g[0], jnp.flip(g[2], -1)], 0)
    log_f = jax.nn.log_sigmoid(jnp.concatenate([g[1], jnp.flip(g[3], -1)], 0))
    both = lambda a: jnp.concatenate([a, jnp.flip(a, 2)], 0)
    return (both(q), both(k), both(v), log_i, log_f), zo


def _mlstm_mixer(z_lat, z_ctx, p, emit_ctx):
    b = z_lat.shape[0]
    ctx_in, o_ctx = _mlstm_prepare(z_ctx, p['mlstm_conv'], p['mlstm_gate_bias'])
    lat_in, o_lat = _mlstm_prepare(z_lat, p['mlstm_conv'], p['mlstm_gate_bias'])
    state0 = (jnp.zeros((2 * b, MLSTM_H, MLSTM_DH, MLSTM_DH), F32),
              jnp.zeros((2 * b, MLSTM_H, MLSTM_DH), F32),
              jnp.zeros((2 * b, MLSTM_H), F32))
    h_ctx, state_ctx = _mlstm_chunked(*ctx_in, state0, emit_ctx)
    h_lat, _ = _mlstm_chunked(*lat_in, state_ctx, True)

    def readout(h2, zo):
        hs = (h2[:b] + jnp.flip(h2[b:], 2)).transpose(0, 2, 1, 3)
        hs = _head_normalize(hs, 1e-6) * p['mlstm_norm_w'].reshape(MLSTM_H, MLSTM_DH)
        return (jax.nn.sigmoid(zo.astype(F32)) * hs.reshape(zo.shape)).astype(zo.dtype)

    y_ctx = readout(h_ctx, o_ctx) if emit_ctx else None
    return readout(h_lat, o_lat), y_ctx


def _rwkv_prepare(z, p):
    b, t, _ = z.shape
    z = _bidir_token_shift(z.astype(F32), p['rwkv_mu'])
    zr, zk, zv, zw, za, zg = _split(z, RWKV_COLS)
    heads = lambda a: a.reshape(b, t, RWKV_H, RWKV_N)
    w_raw = p['rwkv_w0'] + jnp.einsum('btdr,drc->btdc', jnp.tanh(zw.reshape(b, t, 2, DECAY_LORA)), p['rwkv_w_up'])
    decay = jnp.exp(-jnp.exp(-jax.nn.softplus(-w_raw) - 0.5))
    a = jax.nn.sigmoid(p['rwkv_a0'] + jnp.einsum('btdr,drc->btdc', za.reshape(b, t, 2, AAA_LORA), p['rwkv_a_up']))
    g = jax.nn.sigmoid(zg) @ p['rwkv_g_up']
    kk = heads(zk * p['rwkv_k_k'])
    kk = kk * lax.rsqrt(jnp.maximum(jnp.sum(kk * kk, -1, keepdims=True), 1e-12))
    k_dir = (zk[:, :, None, :] * (1.0 + (a - 1.0) * p['rwkv_k_a'])).reshape(b, t, 2, RWKV_H, RWKV_N)
    r = heads(zr)
    v = heads(zv)
    bonus = jnp.einsum('bthn,btdhn->bth', r * p['rwkv_r_k'].reshape(RWKV_H, RWKV_N), k_dir)[..., None] * v
    both = lambda f, bw: jnp.concatenate([f, jnp.flip(bw, 1)], 0)
    seqs = (both(r, r),
            both(heads(decay[:, :, 0]), heads(decay[:, :, 1])),
            both(k_dir[:, :, 0], k_dir[:, :, 1]),
            both(v, v),
            both(kk, kk),
            both(heads(a[:, :, 0]), heads(a[:, :, 1])))
    return seqs, g, bonus


def _rwkv_scan(s0, seqs, emit):
    xs = tuple(jnp.moveaxis(a, 1, 0) for a in seqs)

    def step(s, inp):
        r, w, k, v, kk, a = inp
        s = (s * w[:, :, None, :]
             + jnp.einsum('bhvk,bhk->bhv', s, -kk)[..., None] * (kk * a)[:, :, None, :]
             + v[..., None] * k[:, :, None, :])
        return s, (jnp.einsum('bhvk,bhk->bhv', s, r) if emit else None)

    s, out = lax.scan(step, s0, xs)
    return (jnp.moveaxis(out, 0, 1) if emit else None), s


def _rwkv_mixer(z_lat, z_ctx, p, emit_ctx):
    b = z_lat.shape[0]
    seq_c, g_c, bonus_c = _rwkv_prepare(z_ctx, p)
    seq_l, g_l, bonus_l = _rwkv_prepare(z_lat, p)
    s0 = jnp.zeros((2 * b, RWKV_H, RWKV_N, RWKV_N), F32)
    o_c, s_ctx = _rwkv_scan(s0, seq_c, emit_ctx)
    o_l, _ = _rwkv_scan(s_ctx, seq_l, True)

    def readout(o2, g, bonus, dtype):
        o = o2[:b] + jnp.flip(o2[b:], 1)
        o = (_head_normalize(o, RWKV_GN_EPS) * p['rwkv_ln_w'].reshape(RWKV_H, RWKV_N)
             + p['rwkv_ln_b'].reshape(RWKV_H, RWKV_N) + bonus)
        return (o.reshape(g.shape) * g).astype(dtype)

    y_ctx = readout(o_c, g_c, bonus_c, z_ctx.dtype) if emit_ctx else None
    return readout(o_l, g_l, bonus_l, z_lat.dtype), y_ctx


def _mla_project(z, p, cos=None, sin=None):
    b, t, _ = z.shape
    zq, zkv, k_rope = _split(z, MLA_COLS)
    q = (_rms(zq, p['mla_q_norm']) @ p['mla_w_uq']).reshape(b, t, MLA_H, MLA_NOPE + MLA_ROPE)
    kv = (_rms(zkv, p['mla_kv_norm']) @ p['mla_w_ukv']).reshape(b, t, MLA_H, MLA_NOPE + MLA_V)
    q_nope, q_rope = q[..., :MLA_NOPE], q[..., MLA_NOPE:]
    k_nope, v = kv[..., :MLA_NOPE], kv[..., MLA_NOPE:]
    if cos is not None:
        q_rope = _rope(q_rope, cos[:, None], sin[:, None])
        k_rope = _rope(k_rope, cos, sin)
    q = jnp.concatenate([q_nope, q_rope], -1)
    k = jnp.concatenate([k_nope, jnp.broadcast_to(k_rope[:, :, None, :], (b, t, MLA_H, MLA_ROPE))], -1)
    return q.transpose(0, 2, 1, 3), k.transpose(0, 2, 1, 3), v.transpose(0, 2, 1, 3)


def _softmax_attend(q, k, v):
    s = jnp.einsum('bhqd,bhkd->bhqk', q.astype(F32), k.astype(F32)) * (q.shape[-1] ** -0.5)
    return jnp.einsum('bhqk,bhkd->bhqd', jax.nn.softmax(s, axis=-1).astype(v.dtype), v)


def _mla_mixer(z_lat, z_ctx, p, cos, sin, emit_ctx):
    q_c, k_c, v_c = _mla_project(z_ctx, p)
    q_l, k_l, v_l = _mla_project(z_lat, p, cos, sin)
    b, h, t, dk = q_l.shape
    k_all = jnp.concatenate([k_l, k_c], 2)
    v_all = jnp.concatenate([v_l, v_c], 2)
    q_blocks = jnp.moveaxis(q_l.reshape(b, h, t // Q_BLOCK, Q_BLOCK, dk), 2, 0)
    o = lax.map(lambda qb: _softmax_attend(qb, k_all, v_all), q_blocks)
    y_lat = jnp.moveaxis(o, 0, 2).reshape(b, h, t, MLA_V).transpose(0, 2, 1, 3).reshape(b, t, MLA_W)
    y_ctx = None
    if emit_ctx:
        y_ctx = _softmax_attend(q_c, k_c, v_c).transpose(0, 2, 1, 3).reshape(b, z_ctx.shape[1], MLA_W)
    return y_lat, y_ctx


def _token_mixers(h_lat, h_ctx, p, cos, sin, emit_ctx):
    z_lat = h_lat @ p['w_in']
    z_ctx = h_ctx @ p['w_in']
    zl_m, zl_r, zl_a = _split(z_lat, (N_MLSTM_IN, N_RWKV_IN, N_MLA_IN))
    zc_m, zc_r, zc_a = _split(z_ctx, (N_MLSTM_IN, N_RWKV_IN, N_MLA_IN))
    m_l, m_c = _mlstm_mixer(zl_m, zc_m, p, emit_ctx)
    r_l, r_c = _rwkv_mixer(zl_r, zc_r, p, emit_ctx)
    a_l, a_c = _mla_mixer(zl_a, zc_a, p, cos, sin, emit_ctx)
    y_lat = jnp.concatenate([m_l, r_l, a_l], -1) @ p['w_out']
    y_ctx = jnp.concatenate([m_c, r_c, a_c], -1) @ p['w_out'] if emit_ctx else None
    return y_lat, y_ctx


def _moe(h, p):
    t, d = h.shape
    e_n = N_EXPERTS
    scores = jax.nn.sigmoid(h.astype(F32) @ p['router_w'].astype(F32))
    biased = scores + p['router_bias'].astype(F32)
    group_score = lax.top_k(biased.reshape(t, N_GROUPS, e_n // N_GROUPS), 2)[0].sum(-1)
    _, top_groups = lax.top_k(group_score, TOPK_GROUPS)
    group_mask = jax.nn.one_hot(top_groups, N_GROUPS, dtype=F32).sum(1)
    allowed = jnp.repeat(group_mask, e_n // N_GROUPS, axis=1) > 0
    _, eidx = lax.top_k(jnp.where(allowed, biased, -jnp.inf), TOP_K)
    sel = jnp.take_along_axis(scores, eidx, 1)
    gates = ROUTED_SCALE * sel / sel.sum(-1, keepdims=True)
    n_assign = t * TOP_K
    flat_e = eidx.reshape(n_assign)
    flat_t = jnp.repeat(jnp.arange(t, dtype=jnp.int32), TOP_K)
    flat_g = gates.reshape(n_assign)
    order = jnp.argsort(flat_e)
    sorted_e = flat_e[order]
    counts = jnp.bincount(flat_e, length=e_n)
    padded = (counts + MOE_BLOCK - 1) // MOE_BLOCK * MOE_BLOCK
    ends = jnp.cumsum(padded)
    dest = (ends - padded)[sorted_e] + jnp.arange(n_assign) - (jnp.cumsum(counts) - counts)[sorted_e]
    n_blocks = -(-(n_assign + e_n * (MOE_BLOCK - 1)) // MOE_BLOCK)
    n_rows = n_blocks * MOE_BLOCK
    tok = jnp.full((n_rows,), t, jnp.int32).at[dest].set(flat_t[order])
    gate = jnp.zeros((n_rows,), h.dtype).at[dest].set(flat_g[order].astype(h.dtype))
    block_e = jnp.minimum(jnp.searchsorted(ends, jnp.arange(n_blocks) * MOE_BLOCK, side='right'), e_n - 1)
    h_pad = jnp.concatenate([h, jnp.zeros((1, d), h.dtype)], 0)

    def expert_block(args):
        tb, gb, e = args
        xb = h_pad[tb]
        y = (jax.nn.silu(xb @ p['exp_w_gate'][e]) * (xb @ p['exp_w_up'][e])) @ p['exp_w_down'][e]
        return y * gb[:, None]

    ys = lax.map(expert_block, (tok.reshape(n_blocks, MOE_BLOCK), gate.reshape(n_blocks, MOE_BLOCK), block_e))
    routed = jnp.zeros((t + 1, d), h.dtype).at[tok].add(ys.reshape(n_rows, d))[:t]
    shared = (jax.nn.silu(h @ p['sh_w_gate']) * (h @ p['sh_w_up'])) @ p['sh_w_down']
    return routed + shared


def setup_inputs(seed: int = 0) -> dict:
    key = jax.random.key(seed)
    ks = iter(jax.random.split(key, 48))
    nrm = lambda shape, scale: jax.random.normal(next(ks), shape, F32) * scale
    L, D = DEPTH, D_MODEL
    gate_i = nrm((L, 2, MLSTM_H), 0.1)
    gate_f = jax.random.uniform(next(ks), (L, 2, MLSTM_H), F32, 3.0, 6.0)
    mlstm_gate_bias = jnp.stack([gate_i[:, 0], gate_f[:, 0], gate_i[:, 1], gate_f[:, 1]], 1)
    return {
        'x': nrm((BATCH, SEQ, D), 1.0),
        'c': nrm((BATCH, D), 1.0),
        'ctx': nrm((BATCH, CTX_LEN, D), 1.0),
        'c_ctx': nrm((D,), 1.0),
        'w_mod': nrm((L, D, 6 * D), 0.5 * D ** -0.5),
        'b_mod': nrm((L, 6 * D), 0.01),
        'w_in': nrm((L, D, N_IN), D ** -0.5),
        'mlstm_conv': nrm((L, CONV_W, 2 * MLSTM_W), CONV_W ** -0.5),
        'mlstm_gate_bias': mlstm_gate_bias,
        'mlstm_norm_w': 1.0 + nrm((L, MLSTM_W), 0.1),
        'rwkv_mu': jax.random.uniform(next(ks), (L, N_RWKV_IN), F32),
        'rwkv_w0': jax.random.uniform(next(ks), (L, 2, RWKV_W), F32, -3.0, 1.0),
        'rwkv_w_up': nrm((L, 2, DECAY_LORA, RWKV_W), 0.5 * DECAY_LORA ** -0.5),
        'rwkv_a0': nrm((L, 2, RWKV_W), 0.5),
        'rwkv_a_up': nrm((L, 2, AAA_LORA, RWKV_W), 0.5 * AAA_LORA ** -0.5),
        'rwkv_g_up': nrm((L, GATE_LORA, RWKV_W), GATE_LORA ** -0.5),
        'rwkv_k_k': 0.85 + nrm((L, RWKV_W), 0.1),
        'rwkv_k_a': 1.0 + nrm((L, RWKV_W), 0.1),
        'rwkv_r_k': nrm((L, RWKV_W), 0.1),
        'rwkv_ln_w': 1.0 + nrm((L, RWKV_W), 0.1),
        'rwkv_ln_b': nrm((L, RWKV_W), 0.01),
        'mla_q_norm': 1.0 + nrm((L, Q_RANK), 0.1),
        'mla_kv_norm': 1.0 + nrm((L, KV_RANK), 0.1),
        'mla_w_uq': nrm((L, Q_RANK, MLA_H * (MLA_NOPE + MLA_ROPE)), Q_RANK ** -0.5),
        'mla_w_ukv': nrm((L, KV_RANK, MLA_H * (MLA_NOPE + MLA_V)), KV_RANK ** -0.5),
        'w_out': nrm((L, D_MIX, D), DEEPNORM_BETA * D_MIX ** -0.5),
        'ln1_w': 1.0 + nrm((L, D), 0.1),
        'ln1_b': nrm((L, D), 0.01),
        'router_w': nrm((L, D, N_EXPERTS), D ** -0.5),
        'router_bias': nrm((L, N_EXPERTS), 0.01),
        'exp_w_gate': nrm((L, N_EXPERTS, D, D_EXPERT), D ** -0.5),
        'exp_w_up': nrm((L, N_EXPERTS, D, D_EXPERT), D ** -0.5),
        'exp_w_down': nrm((L, N_EXPERTS, D_EXPERT, D), DEEPNORM_BETA * D_EXPERT ** -0.5),
        'sh_w_gate': nrm((L, D, D_EXPERT), D ** -0.5),
        'sh_w_up': nrm((L, D, D_EXPERT), D ** -0.5),
        'sh_w_down': nrm((L, D_EXPERT, D), DEEPNORM_BETA * D_EXPERT ** -0.5),
        'ln2_w': 1.0 + nrm((L, D), 0.1),
        'ln2_b': nrm((L, D), 0.01),
    }


def reference(x, c, ctx, c_ctx, w_mod, b_mod, w_in, mlstm_conv, mlstm_gate_bias, mlstm_norm_w,
              rwkv_mu, rwkv_w0, rwkv_w_up, rwkv_a0, rwkv_a_up, rwkv_g_up, rwkv_k_k, rwkv_k_a, rwkv_r_k,
              rwkv_ln_w, rwkv_ln_b, mla_q_norm, mla_kv_norm, mla_w_uq, mla_w_ukv, w_out, ln1_w, ln1_b,
              router_w, router_bias, exp_w_gate, exp_w_up, exp_w_down, sh_w_gate, sh_w_up, sh_w_down,
              ln2_w, ln2_b):
    b, n_lat, d = x.shape
    n_ctx = ctx.shape[1]
    cos, sin = _rope_tables(n_lat)
    xc = ctx
    for l in range(DEPTH):
        last = l == DEPTH - 1
        p = {
            'w_in': w_in[l], 'w_out': w_out[l],
            'mlstm_conv': mlstm_conv[l], 'mlstm_gate_bias': mlstm_gate_bias[l], 'mlstm_norm_w': mlstm_norm_w[l],
            'rwkv_mu': rwkv_mu[l], 'rwkv_w0': rwkv_w0[l], 'rwkv_w_up': rwkv_w_up[l], 'rwkv_a0': rwkv_a0[l],
            'rwkv_a_up': rwkv_a_up[l], 'rwkv_g_up': rwkv_g_up[l], 'rwkv_k_k': rwkv_k_k[l], 'rwkv_k_a': rwkv_k_a[l],
            'rwkv_r_k': rwkv_r_k[l], 'rwkv_ln_w': rwkv_ln_w[l], 'rwkv_ln_b': rwkv_ln_b[l],
            'mla_q_norm': mla_q_norm[l], 'mla_kv_norm': mla_kv_norm[l], 'mla_w_uq': mla_w_uq[l], 'mla_w_ukv': mla_w_ukv[l],
        }
        moe_p = {
            'router_w': router_w[l], 'router_bias': router_bias[l], 'exp_w_gate': exp_w_gate[l],
            'exp_w_up': exp_w_up[l], 'exp_w_down': exp_w_down[l], 'sh_w_gate': sh_w_gate[l],
            'sh_w_up': sh_w_up[l], 'sh_w_down': sh_w_down[l],
        }
        sh1, sc1, g1, sh2, sc2, g2 = [m[:, None, :] for m in jnp.split(jax.nn.silu(c) @ w_mod[l] + b_mod[l], 6, axis=-1)]
        csh1, csc1, cg1, csh2, csc2, cg2 = jnp.split(jax.nn.silu(c_ctx) @ w_mod[l] + b_mod[l], 6, axis=-1)
        y_lat, y_ctx = _token_mixers(_modulate(x, sh1, sc1), _modulate(xc, csh1, csc1), p, cos, sin, not last)
        x = _post_norm(x, y_lat, g1, ln1_w[l], ln1_b[l])
        h2_lat = _modulate(x, sh2, sc2).reshape(b * n_lat, d)
        if last:
            f_lat = _moe(h2_lat, moe_p)
        else:
            xc = _post_norm(xc, y_ctx, cg1, ln1_w[l], ln1_b[l])
            h2_ctx = _modulate(xc, csh2, csc2).reshape(b * n_ctx, d)
            f_all = _moe(jnp.concatenate([h2_lat, h2_ctx], 0), moe_p)
            f_lat = f_all[:b * n_lat]
            xc = _post_norm(xc, f_all[b * n_lat:].reshape(b, n_ctx, d), cg2, ln2_w[l], ln2_b[l])
        x = _post_norm(x, f_lat.reshape(b, n_lat, d), g2, ln2_w[l], ln2_b[l])
    return x
```

```cpp
#include <hip/hip_runtime.h>
#include <stdint.h>
#include <stdio.h>

typedef unsigned short u16;
typedef __attribute__((ext_vector_type(8))) short bf16x8;
typedef __attribute__((ext_vector_type(4))) float f32x4;
#define DEVI __device__ __forceinline__
#define LAS __attribute__((address_space(3)))

#define DM 1024
#define TL 4096
#define TC 256
#define RL 16384
#define RT 17408
#define NIN 2608
#define ZC_MV 512
#define ZC_MO 768
#define ZC_MG 1024
#define ZC_RW 1040
#define ZC_MLA 2192
#define NKEY 4352
#define ALPHA 1.41421356237309515f
#define QSCALE (0.10206207261596575f * 1.4426950408889634f)
#define CREC 4224
#define SH_SLOT 139264

constexpr size_t OFF_CTL  = 0;
constexpr size_t OFF_MOD  = 65536;
constexpr size_t OFF_ROPE = OFF_MOD + 245760;
constexpr size_t OFF_XC   = OFF_ROPE + 524288;
constexpr size_t OFF_WTM  = OFF_XC + 4194304;
constexpr size_t WTM_WIN = 0, WTM_UQ = WTM_WIN + (size_t)NIN * 1024, WTM_UKV = WTM_UQ + 768 * 256, WTM_WUP = WTM_UKV + 1024 * 128,
                 WTM_AUP = WTM_WUP + 2 * 256 * 64, WTM_GUP = WTM_AUP + 2 * 256 * 64, WTM_WOUT = WTM_GUP + 256 * 128, WTM_END = WTM_WOUT + 1024 * 1024;
constexpr size_t OFF_H    = OFF_WTM + ((WTM_END * 2 + 255) & ~(size_t)255);
constexpr size_t OFF_S    = OFF_H + (size_t)RT * 1024 * 2;
constexpr size_t S_Z    = OFF_S;
constexpr size_t S_MQ   = S_Z + (size_t)RT * NIN * 2;
constexpr size_t S_MK   = S_MQ + (size_t)RT * 256 * 2;
constexpr size_t S_GL   = S_MK + (size_t)RT * 256 * 2;
constexpr size_t S_CLOC = S_GL + (size_t)RT * 16 * 4;
constexpr size_t S_WD   = S_CLOC + (size_t)32 * 68 * CREC * 4;
constexpr size_t S_KK   = S_WD + (size_t)2 * RT * 256 * 4;
constexpr size_t S_KKA  = S_KK + (size_t)RT * 256 * 2;
constexpr size_t S_KVEC = S_KKA + (size_t)2 * RT * 256 * 2;
constexpr size_t S_RR   = S_KVEC + (size_t)2 * RT * 256 * 2;
constexpr size_t S_RV   = S_RR + (size_t)RT * 256 * 2;
constexpr size_t S_RK   = S_RV + (size_t)RT * 256 * 2;
constexpr size_t S_G    = S_RK + (size_t)RT * 256 * 2;
constexpr size_t S_LI   = S_G + (size_t)RT * 256 * 2;
constexpr size_t S_LA   = S_LI + (size_t)RT * 384 * 2;
constexpr size_t S_OF   = S_LA + (size_t)RT * 384 * 2;
constexpr size_t S_Q    = S_OF + (size_t)2 * RT * 256 * 4;
constexpr size_t S_K    = S_Q + (size_t)32 * NKEY * 96 * 2;
constexpr size_t S_VT   = S_K + (size_t)32 * NKEY * 96 * 2;
constexpr size_t S_MIX_END = S_VT + (size_t)32 * 64 * NKEY * 2;
constexpr size_t S_YEXP = OFF_S;
constexpr size_t S_Y    = OFF_S;
constexpr size_t S_WTE  = S_YEXP + (size_t)(SH_SLOT + RT) * 1024 * 2;
constexpr size_t WTE_PER = 786432;
constexpr size_t S_TOK  = S_WTE + (size_t)65 * WTE_PER * 2;
constexpr size_t S_GATE = S_TOK + (size_t)64 * RT * 4;
constexpr size_t S_SLOT = S_GATE + (size_t)64 * RT * 4;
constexpr size_t S_MOE_END = S_SLOT + (size_t)RT * 8 * 4;
constexpr size_t WS_NEED = (S_MIX_END > S_MOE_END ? S_MIX_END : S_MOE_END);

#define CW_QUEUE(l) (4096 + 64 * (l))
#define CW_CNT(l)   (4352 + 64 * (l))
#define LDS_BYTES 114688

struct Params { const float* in[38]; float* out; unsigned char* ws; };

DEVI int TID() { int t = threadIdx.x; asm volatile("" : "+v"(t)); return t; }
DEVI float bf2f(u16 v) { return __uint_as_float(((unsigned)v) << 16); }
DEVI u16 f2bf(float f) { unsigned u = __float_as_uint(f); u += 0x7fffu + ((u >> 16) & 1u); return (u16)(u >> 16); }
DEVI unsigned pack2(float a, float b) { return (unsigned)f2bf(a) | ((unsigned)f2bf(b) << 16); }
DEVI float wave_sum(float v) {
#pragma unroll
    for (int o = 32; o > 0; o >>= 1) v += __shfl_xor(v, o);
    return v;
}
DEVI float wave_max(float v) {
#pragma unroll
    for (int o = 32; o > 0; o >>= 1) v = fmaxf(v, __shfl_xor(v, o));
    return v;
}
DEVI float sigm(float x) { return 1.f / (1.f + __expf(-x)); }
DEVI float logsig(float x) { return fminf(x, 0.f) - log1pf(__expf(-fabsf(x))); }
template <int CTRL> DEVI float dpp_f(float x) { return __builtin_bit_cast(float, __builtin_amdgcn_update_dpp(0, __builtin_bit_cast(int, x), CTRL, 0xf, 0xf, false)); }
DEVI float red16(float x) {
    x += dpp_f<0xB1>(x); x += dpp_f<0x4E>(x); x += dpp_f<0x141>(x); x += dpp_f<0x140>(x); return x;
}

#define XB_TMO      128
#define XB_XCNT(j)  (256  + 64 * (j))
#define XB_XSUB(j)  (1280 + 64 * (j))
#define XB_XGEN(j)  (2304 + 64 * (j))
#define XB_TOP      3328
#define XB_TOPGEN   3392
#define XB_SPIN_CAP (1u << 27)
DEVI unsigned xb_ld(unsigned* p) { return __hip_atomic_load(p, __ATOMIC_RELAXED, __HIP_MEMORY_SCOPE_AGENT); }
DEVI unsigned xb_add(unsigned* p, unsigned v) { return __hip_atomic_fetch_add(p, v, __ATOMIC_RELAXED, __HIP_MEMORY_SCOPE_AGENT); }
DEVI unsigned xb_xcc_id() { return (unsigned)__builtin_amdgcn_s_getreg((3 << 11) | 20) & 0xFu; }
#define XB_SPIN(cond, bar) do { unsigned _sp = 0; while (cond) { __builtin_amdgcn_s_sleep(2); \
    if ((++_sp & 1023u) == 0u) { if (xb_ld(&(bar)[XB_TMO])) break; if (_sp > XB_SPIN_CAP) { atomicAdd(&(bar)[XB_TMO], 1u); break; } } } } while (0)
struct XcdBarrier { unsigned* bar; unsigned x; volatile LAS unsigned* st; };
DEVI XcdBarrier xcd_barrier_post(unsigned* bar, volatile LAS unsigned* st) {
    XcdBarrier b; b.bar = bar; b.x = xb_xcc_id(); b.st = st;
    if (threadIdx.x == 0) (void)xb_add(&bar[XB_XCNT(b.x)], 1u);
    return b;
}
DEVI void xcd_barrier_complete(unsigned* bar, unsigned x, unsigned& nloc, unsigned& nx) {
    const unsigned G = gridDim.x;
    unsigned sum, cnt, mine, sp = 0u;
    for (;;) {
        sum = 0u; cnt = 0u; mine = 0u;
#pragma unroll
        for (unsigned j = 0; j < 16; ++j) { const unsigned c = xb_ld(&bar[XB_XCNT(j)]); sum += c; cnt += (c > 0u) ? 1u : 0u; mine = (j == x) ? c : mine; }
        if (sum == G) break;
        __builtin_amdgcn_s_sleep(2);
        if ((++sp & 1023u) == 0u) { if (xb_ld(&bar[XB_TMO])) break; if (sp > XB_SPIN_CAP) { atomicAdd(&bar[XB_TMO], 1u); break; } }
    }
    nloc = mine > 0u ? mine : 1u; nx = cnt > 0u ? cnt : 1u;
}
DEVI void xcd_barrier(const XcdBarrier& b) {
    asm volatile("s_waitcnt vmcnt(0)" ::: "memory");
    __syncthreads();
    if (threadIdx.x == 0) {
        unsigned* bar = b.bar;
        __builtin_amdgcn_s_waitcnt(0);
        unsigned nloc = b.st[0], nx = b.st[1];
        if (nloc == 0u) { xcd_barrier_complete(bar, b.x, nloc, nx); b.st[0] = nloc; b.st[1] = nx; }
        const unsigned old = xb_add(&bar[XB_XSUB(b.x)], 1u);
        const unsigned gen = old / nloc;
        if (old + 1u == (gen + 1u) * nloc) {
            __builtin_amdgcn_fence(__ATOMIC_RELEASE, "agent");
            asm volatile("s_waitcnt vmcnt(0)" ::: "memory");
            const unsigned og = xb_add(&bar[XB_TOP], 1u);
            const unsigned tg = og / nx;
            if (og + 1u == (tg + 1u) * nx) xb_add(&bar[XB_TOPGEN], 1u);
            else XB_SPIN(xb_ld(&bar[XB_TOPGEN]) == tg, bar);
            __builtin_amdgcn_fence(__ATOMIC_ACQUIRE, "agent");
            xb_add(&bar[XB_XGEN(b.x)], 1u);
            asm volatile("s_waitcnt vmcnt(0)" ::: "memory");
        } else {
            XB_SPIN(xb_ld(&bar[XB_XGEN(b.x)]) == gen, bar);
            __builtin_amdgcn_fence(__ATOMIC_ACQUIRE, "agent");
            asm volatile("s_waitcnt vmcnt(0)" ::: "memory");
        }
    }
    __syncthreads();
}

struct RowInfo { int b, t, seglen, isctx, mi; };
DEVI RowInfo row_info(int r) {
    RowInfo ri;
    if (r < RL) { ri.b = r >> 12; ri.t = r & 4095; ri.seglen = TL; ri.isctx = 0; ri.mi = ri.b; }
    else { int q = r - RL; ri.b = q >> 8; ri.t = q & 255; ri.seglen = TC; ri.isctx = 1; ri.mi = 4; }
    return ri;
}
DEVI void row_load(const float* row, int lane, float4 (&a)[4]) {
#pragma unroll
    for (int i = 0; i < 4; ++i) a[i] = *(const float4*)(row + (i * 64 + lane) * 4);
}
DEVI void row_ln(float4 (&a)[4]) {
    float s = 0.f;
#pragma unroll
    for (int i = 0; i < 4; ++i) s += a[i].x + a[i].y + a[i].z + a[i].w;
    const float mean = wave_sum(s) * (1.f / 1024.f);
    float q = 0.f;
#pragma unroll
    for (int i = 0; i < 4; ++i) { a[i].x -= mean; a[i].y -= mean; a[i].z -= mean; a[i].w -= mean; q += a[i].x * a[i].x + a[i].y * a[i].y + a[i].z * a[i].z + a[i].w * a[i].w; }
    const float rstd = rsqrtf(wave_sum(q) * (1.f / 1024.f) + 1e-6f);
#pragma unroll
    for (int i = 0; i < 4; ++i) { a[i].x *= rstd; a[i].y *= rstd; a[i].z *= rstd; a[i].w *= rstd; }
}
DEVI void row_affine(float4 (&a)[4], const float* mul, const float* add, int lane, float mul_plus) {
#pragma unroll
    for (int i = 0; i < 4; ++i) {
        const float4 m = *(const float4*)(mul + (i * 64 + lane) * 4), d = *(const float4*)(add + (i * 64 + lane) * 4);
        a[i].x = a[i].x * (m.x + mul_plus) + d.x; a[i].y = a[i].y * (m.y + mul_plus) + d.y; a[i].z = a[i].z * (m.z + mul_plus) + d.z; a[i].w = a[i].w * (m.w + mul_plus) + d.w;
    }
}
DEVI void row_store_bf16(u16* row, int lane, const float4 (&a)[4]) {
#pragma unroll
    for (int i = 0; i < 4; ++i) { uint2 o; o.x = pack2(a[i].x, a[i].y); o.y = pack2(a[i].z, a[i].w); *(uint2*)(row + (i * 64 + lane) * 4) = o; }
}
DEVI void row_store_f32(float* row, int lane, const float4 (&a)[4]) {
#pragma unroll
    for (int i = 0; i < 4; ++i) *(float4*)(row + (i * 64 + lane) * 4) = a[i];
}

#define STG_A 0
#define STG_B 5120
#define STG_BUF 10240
template <bool A_LDS>
DEVI void gemm_core(u16* stage, const u16* pa, const u16* pb, const u16* aLds, int aStride, int K, f32x4 (&acc)[2][4]) {
    const int tid = TID(), lane = tid & 63, w = tid >> 6, wm = w >> 2, wn = w & 3, g = lane >> 4, li = lane & 15;
    const int ldrow = tid >> 2, ldseg = tid & 3;
#pragma unroll
    for (int nt = 0; nt < 2; ++nt)
#pragma unroll
        for (int mt = 0; mt < 4; ++mt) acc[nt][mt] = (f32x4){0.f, 0.f, 0.f, 0.f};
    uint4 ra = make_uint4(0, 0, 0, 0), rb = make_uint4(0, 0, 0, 0);
    if (!A_LDS) { if (pa) ra = *(const uint4*)(pa); }
    if (pb) rb = *(const uint4*)(pb);
    if (!A_LDS) *(uint4*)(stage + STG_A + ldrow * 40 + ldseg * 8) = ra;
    *(uint4*)(stage + STG_B + ldrow * 40 + ldseg * 8) = rb;
    __syncthreads();
    const int nk = K >> 5;
    for (int kt = 0; kt < nk; ++kt) {
        const int bsel = kt & 1;
        if (kt + 1 < nk) {
            if (!A_LDS) { if (pa) ra = *(const uint4*)(pa + (kt + 1) * 32); }
            if (pb) rb = *(const uint4*)(pb + (kt + 1) * 32);
        }
        const u16* As = A_LDS ? (aLds + kt * 32) : (stage + bsel * STG_BUF + STG_A);
        const int as = A_LDS ? aStride : 40;
        const u16* Bs = stage + bsel * STG_BUF + STG_B;
        bf16x8 af[4], bfr[2];
#pragma unroll
        for (int mt = 0; mt < 4; ++mt) af[mt] = *(const bf16x8*)(As + (wm * 64 + mt * 16 + li) * as + g * 8);
#pragma unroll
        for (int nt = 0; nt < 2; ++nt) bfr[nt] = *(const bf16x8*)(Bs + (wn * 32 + nt * 16 + li) * 40 + g * 8);
#pragma unroll
        for (int nt = 0; nt < 2; ++nt)
#pragma unroll
            for (int mt = 0; mt < 4; ++mt) acc[nt][mt] = __builtin_amdgcn_mfma_f32_16x16x32_bf16(bfr[nt], af[mt], acc[nt][mt], 0, 0, 0);
        if (kt + 1 < nk) {
            if (!A_LDS) *(uint4*)(stage + (bsel ^ 1) * STG_BUF + STG_A + ldrow * 40 + ldseg * 8) = ra;
            *(uint4*)(stage + (bsel ^ 1) * STG_BUF + STG_B + ldrow * 40 + ldseg * 8) = rb;
        }
        __syncthreads();
    }
}
#define EPI_M(mt) (wm * 64 + (mt) * 16 + li)
#define EPI_N(nt) (wn * 32 + (nt) * 16 + 4 * g)
#define EPI_IDS const int tid = TID(), lane = tid & 63, w = tid >> 6, wm = w >> 2, wn = w & 3, g = lane >> 4, li = lane & 15; (void)lane;

DEVI void conv_tile(const float* src, int ldn, int K, int N, u16* dst, int rb, int rs16, int tk, int tn, u16* t) {
    const int k0 = tk * 64, n0 = tn * 64, tid = TID();
    const int kr = tid >> 4, nc = (tid & 15) * 4;
#pragma unroll
    for (int hh = 0; hh < 2; ++hh) {
        const int k = k0 + kr + hh * 32;
        float4 v = make_float4(0.f, 0.f, 0.f, 0.f);
        if (n0 + nc < N) v = *(const float4*)(src + (size_t)k * ldn + n0 + nc);
        t[(nc + 0) * 72 + kr + hh * 32] = f2bf(v.x); t[(nc + 1) * 72 + kr + hh * 32] = f2bf(v.y);
        t[(nc + 2) * 72 + kr + hh * 32] = f2bf(v.z); t[(nc + 3) * 72 + kr + hh * 32] = f2bf(v.w);
    }
    __syncthreads();
    const int n = tid >> 3, ks = (tid & 7) * 8;
    if (n0 + n < N) {
        const uint4 o = *(const uint4*)(t + n * 72 + ks);
        const int nn = n0 + n, row = rb + (nn >> 4) * rs16 + (nn & 15);
        *(uint4*)(dst + (size_t)row * K + k0 + ks) = o;
    }
    __syncthreads();
}
DEVI void conv_mixer_item(const Params& p, int l, int it, u16* wtm, u16* t) {
    if (it < 656) { conv_tile(p.in[6] + (size_t)l * 1024 * NIN, NIN, 1024, NIN, wtm + WTM_WIN, 0, 16, it / 41, it % 41, t); return; }
    it -= 656;
    if (it < 48) { conv_tile(p.in[23] + (size_t)l * 256 * 768, 768, 256, 768, wtm + WTM_UQ, 0, 16, it / 12, it % 12, t); return; }
    it -= 48;
    if (it < 32) { conv_tile(p.in[24] + (size_t)l * 128 * 1024, 1024, 128, 1024, wtm + WTM_UKV, 0, 16, it / 16, it % 16, t); return; }
    it -= 32;
    if (it < 8) { const int d = it >> 2; conv_tile(p.in[12] + (size_t)(l * 2 + d) * 64 * 256, 256, 64, 256, wtm + WTM_WUP + d * 256 * 64, 0, 16, 0, it & 3, t); return; }
    it -= 8;
    if (it < 8) { const int d = it >> 2; conv_tile(p.in[14] + (size_t)(l * 2 + d) * 64 * 256, 256, 64, 256, wtm + WTM_AUP + d * 256 * 64, 0, 16, 0, it & 3, t); return; }
    it -= 8;
    if (it < 8) { conv_tile(p.in[15] + (size_t)l * 128 * 256, 256, 128, 256, wtm + WTM_GUP, 0, 16, it >> 2, it & 3, t); return; }
    it -= 8;
    conv_tile(p.in[25] + (size_t)l * 1024 * 1024, 1024, 1024, 1024, wtm + WTM_WOUT, 0, 16, it >> 4, it & 15, t);
}
#define N_CONV_MIXER 1016
DEVI void conv_moe_item(const Params& p, int l, int it, u16* wte, u16* t) {
    const int e = it / 192, r = it % 192;
    u16* w1 = wte + (size_t)e * WTE_PER; u16* w2 = w1 + 512 * 1024;
    if (r < 64) {
        const float* src = (e < 64) ? p.in[30] + (size_t)(l * 64 + e) * 1024 * 256 : p.in[33] + (size_t)l * 1024 * 256;
        conv_tile(src, 256, 1024, 256, w1, 0, 32, r >> 2, r & 3, t);
    } else if (r < 128) {
        const float* src = (e < 64) ? p.in[31] + (size_t)(l * 64 + e) * 1024 * 256 : p.in[34] + (size_t)l * 1024 * 256;
        conv_tile(src, 256, 1024, 256, w1, 16, 32, (r - 64) >> 2, (r - 64) & 3, t);
    } else {
        const float* src = (e < 64) ? p.in[32] + (size_t)(l * 64 + e) * 256 * 1024 : p.in[35] + (size_t)l * 256 * 1024;
        conv_tile(src, 1024, 256, 1024, w2, 0, 16, (r - 128) >> 4, (r - 128) & 15, t);
    }
}
#define N_CONV_MOE 12480

DEVI void phase_mods(const Params& p, float* MOD, float* ROPE, float* ldsf) {
    const int tidx = TID();
    for (int it = blockIdx.x; it < 192; it += gridDim.x) {
        const int l = it / 96, n0 = (it % 96) * 64;
        for (int i = tidx; i < 5 * 1024; i += 512) { const int r = i >> 10, k = i & 1023; const float c = (r < 4) ? p.in[1][r * 1024 + k] : p.in[3][k]; ldsf[i] = c / (1.f + __expf(-c)); }
        __syncthreads();
        const int col = tidx & 63, ks = tidx >> 6;
        const float* wp = p.in[4] + (size_t)l * 1024 * 6144 + n0 + col;
        float acc[5] = {0.f, 0.f, 0.f, 0.f, 0.f};
        for (int k = ks * 128; k < ks * 128 + 128; ++k) {
            const float wv = wp[(size_t)k * 6144];
#pragma unroll
            for (int i = 0; i < 5; ++i) acc[i] += ldsf[i * 1024 + k] * wv;
        }
        float* red = ldsf + 5120;
#pragma unroll
        for (int i = 0; i < 5; ++i) red[(ks * 5 + i) * 64 + col] = acc[i];
        __syncthreads();
        if (tidx < 320) {
            const int i = tidx >> 6; float s = 0.f;
#pragma unroll
            for (int k2 = 0; k2 < 8; ++k2) s += red[(k2 * 5 + i) * 64 + col];
            MOD[(l * 5 + i) * 6144 + n0 + col] = s + p.in[5][l * 6144 + n0 + col];
        }
        __syncthreads();
    }
    for (int idx = blockIdx.x * 512 + tidx; idx < 4096 * 16; idx += gridDim.x * 512) {
        const int t = idx >> 4, i = idx & 15;
        const float pos = (float)((i < 8) ? (t >> 6) : (t & 63));
        const float freq = powf(10000.f, -(float)(i & 7) / 8.f);
        float s, c; sincosf(pos * freq, &s, &c);
        ROPE[idx * 2] = c; ROPE[idx * 2 + 1] = s;
    }
}

DEVI void mlstm_local_item(const Params& p, int l, int item, const u16* Z, u16* MQ, u16* MK, float* GL, float* CLOC, float* lf) {
    const int tid = TID();
    const int tb = item % 68, h = (item / 68) & 3, b = item / 272;
    const int rowbase = (tb < 4) ? (RL + b * 256 + tb * 64) : (b * 4096 + (tb - 4) * 64);
    const int seglen = (tb < 4) ? TC : TL, tl0 = (tb < 4) ? tb * 64 : (tb - 4) * 64;
    float* kS = lf;
    float* vS = lf + 4096;
    float* gl = lf + 8192;
    float* eS = lf + 8448;
    float* sc = lf + 8576;
    {
        const int c = tid & 63, which = (tid >> 6) & 1, tg = tid >> 7;
        const int ch = which * 256 + h * 64 + c;
        const float w0 = p.in[7][(l * 3 + 0) * 512 + ch], w1 = p.in[7][(l * 3 + 1) * 512 + ch], w2 = p.in[7][(l * 3 + 2) * 512 + ch];
        const int t0 = tg * 16;
        float zm, z0, zp;
        { const int tl = tl0 + t0 - 1; zm = (tl >= 0) ? bf2f(Z[(size_t)(rowbase + t0 - 1) * NIN + ch]) : 0.f; }
        z0 = bf2f(Z[(size_t)(rowbase + t0) * NIN + ch]);
        for (int i = 0; i < 16; ++i) {
            const int t = t0 + i, tl = tl0 + t + 1;
            zp = (tl < seglen) ? bf2f(Z[(size_t)(rowbase + t + 1) * NIN + ch]) : 0.f;
            const float y = w0 * zm + w1 * z0 + w2 * zp;
            float s = y / (1.f + __expf(-y));
            if (which == 0) { MQ[(size_t)(rowbase + t) * 256 + h * 64 + c] = f2bf(s * 0.125f); }
            else { MK[(size_t)(rowbase + t) * 256 + h * 64 + c] = f2bf(s); kS[t * 64 + c] = s; }
            zm = z0; z0 = zp;
        }
        for (int i = tid; i < 4096; i += 512) { const int t = i >> 6, cc = i & 63; vS[i] = bf2f(Z[(size_t)(rowbase + t) * NIN + ZC_MV + h * 64 + cc]); }
        if (tid < 64) {
            const u16* zr = Z + (size_t)(rowbase + tid) * NIN + ZC_MG;
            const float* gb = p.in[8] + l * 16;
            const float lif = bf2f(zr[0 + h]) + gb[0 + h], lff = logsig(bf2f(zr[4 + h]) + gb[4 + h]);
            const float lib = bf2f(zr[8 + h]) + gb[8 + h], lfb = logsig(bf2f(zr[12 + h]) + gb[12 + h]);
            gl[tid] = lif; gl[64 + tid] = lff; gl[128 + tid] = lib; gl[192 + tid] = lfb;
            *(float4*)(GL + (size_t)(rowbase + tid) * 16 + h * 4) = make_float4(lif, lff, lib, lfb);
        }
    }
    __syncthreads();
    if (tid < 128) {
        const int dir = tid >> 6, s = tid & 63, tau = dir ? 63 - s : s;
        float bc = gl[(1 + 2 * dir) * 64 + tau];
#pragma unroll
        for (int o = 1; o < 64; o <<= 1) { const float u = __shfl_up(bc, o); if (s >= o) bc += u; }
        const float bend = __shfl(bc, 63);
        const float we = bend - bc + gl[(2 * dir) * 64 + tau];
        const float ml = wave_max(we);
        eS[dir * 64 + tau] = __expf(we - ml);
        if (s == 0) { sc[dir * 2] = ml; sc[dir * 2 + 1] = bend; }
    }
    __syncthreads();
#pragma unroll 1
    for (int dir = 0; dir < 2; ++dir) {
        const int c = dir ? ((tb < 4) ? 3 - tb : 71 - tb) : tb;
        const int seq = (dir * 4 + b) * 4 + h;
        float* rec = CLOC + (size_t)(seq * 68 + c) * CREC;
        const int v = tid >> 3, k0 = (tid & 7) * 8;
        float acc[8];
#pragma unroll
        for (int j = 0; j < 8; ++j) acc[j] = 0.f;
        for (int t = 0; t < 64; ++t) {
            const float ev = eS[dir * 64 + t] * vS[t * 64 + v];
            const float4 ka = *(const float4*)(kS + t * 64 + k0), kb = *(const float4*)(kS + t * 64 + k0 + 4);
            acc[0] += ev * ka.x; acc[1] += ev * ka.y; acc[2] += ev * ka.z; acc[3] += ev * ka.w;
            acc[4] += ev * kb.x; acc[5] += ev * kb.y; acc[6] += ev * kb.z; acc[7] += ev * kb.w;
        }
        *(float4*)(rec + v * 64 + k0) = make_float4(acc[0], acc[1], acc[2], acc[3]);
        *(float4*)(rec + v * 64 + k0 + 4) = make_float4(acc[4], acc[5], acc[6], acc[7]);
        if (tid < 64) {
            float n = 0.f;
            for (int t = 0; t < 64; ++t) n += eS[dir * 64 + t] * kS[t * 64 + tid];
            rec[4096 + tid] = n;
        }
        if (tid == 64) { rec[4160] = sc[dir * 2]; rec[4161] = sc[dir * 2 + 1]; }
    }
    __syncthreads();
}
DEVI void mlstm_scan_item(int item, float* CLOC, float* lf) {
    const int tid = TID(), seq = item / 9, sl = item % 9;
    float* base = CLOC + (size_t)seq * 68 * CREC;
    float* ao = lf; float* al = lf + 68; float* mp = lf + 136;
    if (tid < 68) { ao[tid] = base[(size_t)tid * CREC + 4160]; al[tid] = base[(size_t)tid * CREC + 4161]; }
    __syncthreads();
    if (tid == 0) {
        float m = 0.f;
        for (int c = 0; c < 68; ++c) {
            const float ml = ao[c], be = al[c];
            const float mn = fmaxf(be + m, ml);
            mp[c] = m; ao[c] = __expf(be + m - mn); al[c] = __expf(ml - mn); m = mn;
        }
    }
    __syncthreads();
    if (sl == 8 && tid < 68) base[(size_t)tid * CREC + 4162] = mp[tid];
    const bool act = (sl < 8) || (tid < 64);
    const int e = (sl < 8) ? sl * 512 + tid : 4096 + tid;
    float st = 0.f;
    if (act) {
#pragma unroll 1
        for (int c0 = 0; c0 < 68; c0 += 17) {
            float v[17];
#pragma unroll
            for (int j = 0; j < 17; ++j) v[j] = base[(size_t)(c0 + j) * CREC + e];
#pragma unroll
            for (int j = 0; j < 17; ++j) { base[(size_t)(c0 + j) * CREC + e] = st; st = ao[c0 + j] * st + al[c0 + j] * v[j]; }
        }
    }
    __syncthreads();
}
DEVI void mlstm_out_item(const Params& p, int l, int b, int h, int tb, const u16* Z, const u16* MQ, const u16* MK, const float* GL, const float* CLOC, u16* MIX, float* lf) {
    const int tid = TID();
    const int rowbase = (tb < 4) ? (RL + b * 256 + tb * 64) : (b * 4096 + (tb - 4) * 64);
    float* qS = lf;
    float* kS = qS + 4160;
    float* vS = kS + 4160;
    float* Cp = vS + 4096;
    float* Sm = Cp + 4160;
    float* hs = Sm + 4160;
    float* np = hs + 4160;
    float* bc = np + 64;
    float* lis = bc + 64;
    float* mrow = lis + 64;
    float* eint = mrow + 64;
    for (int i = tid; i < 4096; i += 512) {
        const int t = i >> 6, c = i & 63;
        qS[t * 65 + c] = bf2f(MQ[(size_t)(rowbase + t) * 256 + h * 64 + c]);
        kS[t * 65 + c] = bf2f(MK[(size_t)(rowbase + t) * 256 + h * 64 + c]);
        vS[t * 64 + c] = bf2f(Z[(size_t)(rowbase + t) * NIN + ZC_MV + h * 64 + c]);
        hs[t * 65 + c] = 0.f;
    }
    __syncthreads();
#pragma unroll 1
    for (int dir = 0; dir < 2; ++dir) {
        const int c = dir ? ((tb < 4) ? 3 - tb : 71 - tb) : tb;
        const int seq = (dir * 4 + b) * 4 + h;
        const float* rec = CLOC + (size_t)(seq * 68 + c) * CREC;
        const float mprev = rec[4162];
        for (int i = tid; i < 4096; i += 512) Cp[(i >> 6) * 65 + (i & 63)] = rec[i];
        if (tid < 64) np[tid] = rec[4096 + tid];
        if (tid < 64) {
            const int s = tid, tau = dir ? 63 - s : s;
            const float4 gv = *(const float4*)(GL + (size_t)(rowbase + tau) * 16 + h * 4);
            const float li = dir ? gv.z : gv.x, lfv = dir ? gv.w : gv.y;
            float cum = lfv;
#pragma unroll
            for (int o = 1; o < 64; o <<= 1) { const float u = __shfl_up(cum, o); if (s >= o) cum += u; }
            float pm = li - cum;
#pragma unroll
            for (int o = 1; o < 64; o <<= 1) { const float u = __shfl_up(pm, o); if (s >= o) pm = fmaxf(pm, u); }
            const float glog = cum + mprev, mr = fmaxf(glog, cum + pm);
            bc[s] = cum; lis[s] = li; mrow[s] = mr; eint[s] = __expf(glog - mr);
        }
        __syncthreads();
        {
            const int j = tid >> 3, s0 = (tid & 7) * 8;
            const int tj = dir ? 63 - j : j;
            float acc[8];
#pragma unroll
            for (int i = 0; i < 8; ++i) acc[i] = 0.f;
            if (s0 <= j) {
                for (int d = 0; d < 64; ++d) {
                    const float qv = qS[tj * 65 + d];
#pragma unroll
                    for (int i = 0; i < 8; ++i) { const int ts = dir ? 63 - (s0 + i) : (s0 + i); acc[i] += qv * kS[ts * 65 + d]; }
                }
            }
#pragma unroll
            for (int i = 0; i < 8; ++i) {
                const int s = s0 + i;
                Sm[j * 65 + s] = (s <= j) ? __expf(bc[j] - bc[s] + lis[s] - mrow[j]) * acc[i] : 0.f;
            }
        }
        __syncthreads();
        {
            const int j = tid >> 3, v0 = (tid & 7) * 8;
            const int tj = dir ? 63 - j : j;
            float acc[8];
#pragma unroll
            for (int i = 0; i < 8; ++i) acc[i] = 0.f;
            float den = 0.f;
            for (int s = 0; s <= j; ++s) {
                const float wv = Sm[j * 65 + s]; den += wv;
                const int ts = dir ? 63 - s : s;
                const float4 va = *(const float4*)(vS + ts * 64 + v0), vb = *(const float4*)(vS + ts * 64 + v0 + 4);
                acc[0] += wv * va.x; acc[1] += wv * va.y; acc[2] += wv * va.z; acc[3] += wv * va.w;
                acc[4] += wv * vb.x; acc[5] += wv * vb.y; acc[6] += wv * vb.z; acc[7] += wv * vb.w;
            }
            float ia[8];
#pragma unroll
            for (int i = 0; i < 8; ++i) ia[i] = 0.f;
            float nq = 0.f;
            for (int k = 0; k < 64; ++k) {
                const float qv = qS[tj * 65 + k]; nq += np[k] * qv;
#pragma unroll
                for (int i = 0; i < 8; ++i) ia[i] += Cp[(v0 + i) * 65 + k] * qv;
            }
            const float ei = eint[j];
            den += ei * nq;
            const float dn = 1.f / fmaxf(fabsf(den), __expf(-mrow[j]));
#pragma unroll
            for (int i = 0; i < 8; ++i) hs[tj * 65 + v0 + i] += (acc[i] + ei * ia[i]) * dn;
        }
        __syncthreads();
    }
    {
        const int t = tid >> 3, v0 = (tid & 7) * 8;
        float x[8]; float s = 0.f;
#pragma unroll
        for (int i = 0; i < 8; ++i) { x[i] = hs[t * 65 + v0 + i]; s += x[i]; }
        s += __shfl_xor(s, 1); s += __shfl_xor(s, 2); s += __shfl_xor(s, 4);
        const float mean = s * (1.f / 64.f);
        float q = 0.f;
#pragma unroll
        for (int i = 0; i < 8; ++i) { x[i] -= mean; q += x[i] * x[i]; }
        q += __shfl_xor(q, 1); q += __shfl_xor(q, 2); q += __shfl_xor(q, 4);
        const float rstd = rsqrtf(q * (1.f / 64.f) + 1e-6f);
        const u16* zo = Z + (size_t)(rowbase + t) * NIN + ZC_MO + h * 64 + v0;
        const float* nw = p.in[9] + l * 256 + h * 64 + v0;
        unsigned o[4];
#pragma unroll
        for (int i = 0; i < 4; ++i) {
            const float a0 = sigm(bf2f(zo[2 * i])) * x[2 * i] * rstd * nw[2 * i];
            const float a1 = sigm(bf2f(zo[2 * i + 1])) * x[2 * i + 1] * rstd * nw[2 * i + 1];
            o[i] = pack2(a0, a1);
        }
        *(uint4*)(MIX + (size_t)(rowbase + t) * 1024 + h * 64 + v0) = make_uint4(o[0], o[1], o[2], o[3]);
    }
    __syncthreads();
}

DEVI void prep_row(const Params& p, int l, int r, int lane, const u16* Z, u16* RR, u16* RK, u16* RV, u16* KK, u16* LI, u16* LA, u16* Kb, const float* ROPE) {
    const RowInfo ri = row_info(r);
    const u16* z0 = Z + (size_t)r * NIN;
    const bool hp = ri.t > 0, hn = ri.t < ri.seglen - 1;
    const float* mu = p.in[10] + l * 1152;
#pragma unroll
    for (int i = 0; i < 18; ++i) {
        const int c = lane + 64 * i;
        const float zc = bf2f(z0[ZC_RW + c]);
        const float zp = hp ? bf2f(z0[ZC_RW + c - NIN]) : 0.f, zn = hn ? bf2f(z0[ZC_RW + c + NIN]) : 0.f;
        const float zs = zc + mu[c] * (0.5f * (zp + zn) - zc);
        if (i < 4) RR[(size_t)r * 256 + c] = f2bf(zs);
        else if (i < 8) {
            RK[(size_t)r * 256 + c - 256] = f2bf(zs);
            const float kr = zs * p.in[16][l * 256 + c - 256];
            const float ss = wave_sum(kr * kr);
            KK[(size_t)r * 256 + c - 256] = f2bf(kr * rsqrtf(fmaxf(ss, 1e-12f)));
        }
        else if (i < 12) RV[(size_t)r * 256 + c - 512] = f2bf(zs);
        else if (i < 14) LI[(size_t)r * 384 + c - 768] = f2bf(tanhf(zs));
        else if (i < 16) LI[(size_t)r * 384 + 128 + c - 896] = f2bf(zs);
        else LI[(size_t)r * 384 + 256 + c - 1024] = f2bf(sigm(zs));
    }
    {
        float zq[4]; float s = 0.f;
#pragma unroll
        for (int i = 0; i < 4; ++i) { zq[i] = bf2f(z0[ZC_MLA + lane + 64 * i]); s += zq[i] * zq[i]; }
        float rs = rsqrtf(wave_sum(s) * (1.f / 256.f) + 1e-6f);
#pragma unroll
        for (int i = 0; i < 4; ++i) LA[(size_t)r * 384 + lane + 64 * i] = f2bf(zq[i] * rs * p.in[21][l * 256 + lane + 64 * i]);
        float zk[2]; s = 0.f;
#pragma unroll
        for (int i = 0; i < 2; ++i) { zk[i] = bf2f(z0[ZC_MLA + 256 + lane + 64 * i]); s += zk[i] * zk[i]; }
        rs = rsqrtf(wave_sum(s) * (1.f / 128.f) + 1e-6f);
#pragma unroll
        for (int i = 0; i < 2; ++i) LA[(size_t)r * 384 + 256 + lane + 64 * i] = f2bf(zk[i] * rs * p.in[22][l * 128 + lane + 64 * i]);
        const float x = (lane < 32) ? bf2f(z0[ZC_MLA + 384 + lane]) : 0.f;
        const float xo = __shfl_xor(x, 1);
        float o = x;
        if (!ri.isctx) {
            const int pi = (lane & 31) >> 1;
            const float cs = ROPE[(ri.t * 16 + pi) * 2], sn = ROPE[(ri.t * 16 + pi) * 2 + 1];
            o = (lane & 1) ? (xo * sn + x * cs) : (x * cs - xo * sn);
        }
        if (lane < 32) {
            const int idx = ri.isctx ? 4096 + ri.t : ri.t;
            const u16 ob = f2bf(o);
#pragma unroll
            for (int hh = 0; hh < 8; ++hh) Kb[((size_t)(ri.b * 8 + hh) * NKEY + idx) * 96 + 64 + lane] = ob;
        }
    }
}

#define RW_TB 32
DEVI void rwkv_scan_block(int bk, const float* WD, const u16* KK, const u16* KKA, const u16* KVEC, const u16* RR, const u16* RV, float* OFB, float* lf) {
    const int tid = TID(), lane = tid & 63, w = tid >> 6;
    const int seq = bk >> 1, half = bk & 1;
    const int dir = seq >> 4, b = (seq >> 2) & 3, h = seq & 3;
    const int kq = lane & 15, rr = lane >> 4;
    const int vrow = 32 * half + 4 * w + rr;
    const float* wd = WD + (size_t)dir * RT * 256 + h * 64;
    const u16* kk = KK + h * 64; const u16* kka = KKA + (size_t)dir * RT * 256 + h * 64; const u16* kvec = KVEC + (size_t)dir * RT * 256 + h * 64;
    const u16* rrp = RR + h * 64; const u16* rvp = RV + h * 64;
    float* outp = OFB + (size_t)dir * RT * 256 + h * 64 + vrow;
    const int lstep = tid >> 4, lpart = tid & 15;
    float4 pw; uint2 pk, pka, pkv, pr, pv;
    auto srow = [&](int s) -> int { return (s < 256) ? (RL + b * 256 + (dir ? 255 - s : s)) : (b * 4096 + (dir ? 4095 - (s - 256) : (s - 256))); };
    auto gload = [&](int s0) {
        const size_t ro = (size_t)srow(s0 + lstep) * 256 + lpart * 4;
        pw = *(const float4*)(wd + ro); pk = *(const uint2*)(kk + ro); pka = *(const uint2*)(kka + ro); pkv = *(const uint2*)(kvec + ro);
        pr = *(const uint2*)(rrp + ro); pv = *(const uint2*)(rvp + ro);
    };
    auto up = [&](uint2 v) -> float4 { return make_float4(__uint_as_float(v.x << 16), __uint_as_float(v.x & 0xffff0000u), __uint_as_float(v.y << 16), __uint_as_float(v.y & 0xffff0000u)); };
    auto lstore = [&](int bsel) {
        float* d = lf + bsel * (RW_TB * 384) + lstep * 384 + lpart * 4;
        *(float4*)(d) = pw; *(float4*)(d + 64) = up(pk); *(float4*)(d + 128) = up(pka); *(float4*)(d + 192) = up(pkv); *(float4*)(d + 256) = up(pr); *(float4*)(d + 320) = up(pv);
    };
    float S0 = 0.f, S1 = 0.f, S2 = 0.f, S3 = 0.f;
    gload(0); lstore(0); __syncthreads();
    const int nb = NKEY / RW_TB;
#pragma unroll 1
    for (int bt = 0; bt < nb; ++bt) {
        const int bsel = bt & 1;
        if (bt + 1 < nb) gload((bt + 1) * RW_TB);
        const float* base = lf + bsel * (RW_TB * 384);
#pragma unroll 4
        for (int s = 0; s < RW_TB; ++s) {
            const float* o = base + s * 384 + kq * 4;
            const float4 w4 = *(const float4*)(o), k4 = *(const float4*)(o + 64), a4 = *(const float4*)(o + 128), c4 = *(const float4*)(o + 192), r4 = *(const float4*)(o + 256);
            const float vv = base[s * 384 + 320 + vrow];
            float d = S0 * k4.x + S1 * k4.y + S2 * k4.z + S3 * k4.w;
            d = -red16(d);
            S0 = S0 * w4.x + d * a4.x + vv * c4.x; S1 = S1 * w4.y + d * a4.y + vv * c4.y;
            S2 = S2 * w4.z + d * a4.z + vv * c4.z; S3 = S3 * w4.w + d * a4.w + vv * c4.w;
            float ov = S0 * r4.x + S1 * r4.y + S2 * r4.z + S3 * r4.w;
            ov = red16(ov);
            if (kq == 0) outp[(size_t)srow(bt * RW_TB + s) * 256] = ov;
        }
        if (bt + 1 < nb) lstore(bsel ^ 1);
        __syncthreads();
    }
}

DEVI void attn_item(int b, int h, int q0, int key0, int nkt, int outrow0, const u16* Qb, const u16* Kb, const u16* VTb, u16* MIX, u16* ls) {
    const int tid = TID(), lane = tid & 63, w = tid >> 6, g = lane >> 4, li = lane & 15;
    const u16* Qh = Qb + (size_t)(b * 8 + h) * NKEY * 96;
    const u16* Kh = Kb + (size_t)(b * 8 + h) * NKEY * 96;
    const u16* Vh = VTb + (size_t)(b * 8 + h) * 64 * NKEY;
    u16* Ks = ls; u16* Vs = ls + 2 * 64 * 104;
    bf16x8 qf[3];
#pragma unroll
    for (int ks = 0; ks < 3; ++ks) qf[ks] = *(const bf16x8*)(Qh + (size_t)(q0 + 16 * w + li) * 96 + ks * 32 + g * 8);
    uint4 rk0, rk1 = make_uint4(0, 0, 0, 0), rv;
    const int kr0 = tid / 12, kc0 = tid % 12, kr1 = (tid + 512) / 12, kc1 = (tid + 512) % 12;
    const int vr = tid >> 3, vc = tid & 7;
    auto gload = [&](int kt) {
        const int kb = key0 + kt * 64;
        rk0 = *(const uint4*)(Kh + (size_t)(kb + kr0) * 96 + kc0 * 8);
        if (tid < 256) rk1 = *(const uint4*)(Kh + (size_t)(kb + kr1) * 96 + kc1 * 8);
        rv = *(const uint4*)(Vh + (size_t)vr * NKEY + kb + vc * 8);
    };
    auto lstore = [&](int bsel) {
        *(uint4*)(Ks + bsel * 64 * 104 + kr0 * 104 + kc0 * 8) = rk0;
        if (tid < 256) *(uint4*)(Ks + bsel * 64 * 104 + kr1 * 104 + kc1 * 8) = rk1;
        *(uint4*)(Vs + bsel * 64 * 72 + vr * 72 + vc * 8) = rv;
    };
    f32x4 oacc[4];
#pragma unroll
    for (int mt = 0; mt < 4; ++mt) oacc[mt] = (f32x4){0.f, 0.f, 0.f, 0.f};
    float m = -1e30f, lsum = 0.f;
    gload(0); lstore(0); __syncthreads();
#pragma unroll 1
    for (int kt = 0; kt < nkt; ++kt) {
        const int bsel = kt & 1;
        if (kt + 1 < nkt) gload(kt + 1);
        const u16* K0 = Ks + bsel * 64 * 104; const u16* V0 = Vs + bsel * 64 * 72;
        f32x4 st[4];
#pragma unroll
        for (int k4 = 0; k4 < 4; ++k4) {
            st[k4] = (f32x4){0.f, 0.f, 0.f, 0.f};
#pragma unroll
            for (int ks = 0; ks < 3; ++ks) {
                const bf16x8 a = *(const bf16x8*)(K0 + (k4 * 16 + li) * 104 + ks * 32 + g * 8);
                st[k4] = __builtin_amdgcn_mfma_f32_16x16x32_bf16(a, qf[ks], st[k4], 0, 0, 0);
            }
        }
        float mx = -1e30f;
#pragma unroll
        for (int k4 = 0; k4 < 4; ++k4)
#pragma unroll
            for (int j = 0; j < 4; ++j) mx = fmaxf(mx, st[k4][j]);
        mx = fmaxf(mx, __shfl_xor(mx, 16)); mx = fmaxf(mx, __shfl_xor(mx, 32));
        const float mn = fmaxf(m, mx);
        const float alpha = exp2f(m - mn);
        m = mn;
        float ps = 0.f;
#pragma unroll
        for (int k4 = 0; k4 < 4; ++k4)
#pragma unroll
            for (int j = 0; j < 4; ++j) { const float pv = exp2f(st[k4][j] - mn); st[k4][j] = pv; ps += pv; }
        lsum = lsum * alpha + ps;
#pragma unroll
        for (int mt = 0; mt < 4; ++mt) { oacc[mt][0] *= alpha; oacc[mt][1] *= alpha; oacc[mt][2] *= alpha; oacc[mt][3] *= alpha; }
#pragma unroll
        for (int pp = 0; pp < 2; ++pp) {
            union { bf16x8 v; unsigned u[4]; } pf;
            pf.u[0] = pack2(st[2 * pp][0], st[2 * pp][1]); pf.u[1] = pack2(st[2 * pp][2], st[2 * pp][3]);
            pf.u[2] = pack2(st[2 * pp + 1][0], st[2 * pp + 1][1]); pf.u[3] = pack2(st[2 * pp + 1][2], st[2 * pp + 1][3]);
#pragma unroll
            for (int mt = 0; mt < 4; ++mt) {
                union { bf16x8 v; uint2 u[2]; } vf;
                vf.u[0] = *(const uint2*)(V0 + (mt * 16 + li) * 72 + 32 * pp + 4 * g);
                vf.u[1] = *(const uint2*)(V0 + (mt * 16 + li) * 72 + 32 * pp + 16 + 4 * g);
                oacc[mt] = __builtin_amdgcn_mfma_f32_16x16x32_bf16(vf.v, pf.v, oacc[mt], 0, 0, 0);
            }
        }
        if (kt + 1 < nkt) lstore(bsel ^ 1);
        __syncthreads();
    }
    lsum += __shfl_xor(lsum, 16); lsum += __shfl_xor(lsum, 32);
    const float inv = 1.f / lsum;
    u16* orow = MIX + (size_t)(outrow0 + 16 * w + li) * 1024 + 512 + h * 64;
#pragma unroll
    for (int mt = 0; mt < 4; ++mt) {
        uint2 o; o.x = pack2(oacc[mt][0] * inv, oacc[mt][1] * inv); o.y = pack2(oacc[mt][2] * inv, oacc[mt][3] * inv);
        *(uint2*)(orow + mt * 16 + 4 * g) = o;
    }
}

#define CTL  ((unsigned*)(ws + OFF_CTL))
#define MOD  ((float*)(ws + OFF_MOD))
#define ROPE ((float*)(ws + OFF_ROPE))
#define XC   ((float*)(ws + OFF_XC))
#define WTM  ((u16*)(ws + OFF_WTM))
#define H    ((u16*)(ws + OFF_H))
#define MIX  ((u16*)(ws + OFF_H))
#define Z    ((u16*)(ws + S_Z))
#define MQ   ((u16*)(ws + S_MQ))
#define MK   ((u16*)(ws + S_MK))
#define GL   ((float*)(ws + S_GL))
#define CLOC ((float*)(ws + S_CLOC))
#define WD   ((float*)(ws + S_WD))
#define KK   ((u16*)(ws + S_KK))
#define KKA  ((u16*)(ws + S_KKA))
#define KVEC ((u16*)(ws + S_KVEC))
#define RR   ((u16*)(ws + S_RR))
#define RV   ((u16*)(ws + S_RV))
#define RK   ((u16*)(ws + S_RK))
#define GG   ((u16*)(ws + S_G))
#define LI   ((u16*)(ws + S_LI))
#define LA   ((u16*)(ws + S_LA))
#define OFB  ((float*)(ws + S_OF))
#define Qb   ((u16*)(ws + S_Q))
#define Kb   ((u16*)(ws + S_K))
#define VTb  ((u16*)(ws + S_VT))
#define Y    ((float*)(ws + S_Y))
#define YEXP ((u16*)(ws + S_YEXP))
#define WTE  ((u16*)(ws + S_WTE))
#define TOK  ((int*)(ws + S_TOK))
#define GATE ((float*)(ws + S_GATE))
#define SLOT ((int*)(ws + S_SLOT))

__global__ void __launch_bounds__(512) mega(Params p) {
    __shared__ __attribute__((aligned(16))) unsigned char lds[LDS_BYTES];
    int tid = threadIdx.x, lane = tid & 63, wv = tid >> 6;
    const int G = gridDim.x, bid = blockIdx.x;
#define REFRESH() do { asm volatile("" : "+v"(tid)); lane = tid & 63; wv = tid >> 6; } while (0)
    unsigned char* ws = p.ws;
    float* lf = (float*)lds; u16* ls = (u16*)lds;
    volatile LAS unsigned* bst = (volatile LAS unsigned*)(lds + LDS_BYTES - 16);
    int* misc = (int*)(lds + LDS_BYTES - 64);
    if (tid < 4) bst[tid] = 0u;
    __syncthreads();
    XcdBarrier bar = xcd_barrier_post(CTL, bst);
#define x_in (p.in[0])
#define ctx_in (p.in[2])
#define OUT (p.out)

    phase_mods(p, MOD, ROPE, lf);
    for (int it = bid; it < N_CONV_MIXER; it += G) conv_mixer_item(p, 0, it, WTM, ls);
    xcd_barrier(bar);
    for (int r = bid * 8 + wv; r < RT; r += G * 8) {
        const RowInfo ri = row_info(r);
        const float* xr = ri.isctx ? ctx_in + (size_t)(r - RL) * 1024 : x_in + (size_t)r * 1024;
        float4 a[4]; row_load(xr, lane, a); row_ln(a);
        const float* md = MOD + (0 * 5 + ri.mi) * 6144;
        row_affine(a, md + 1024, md, lane, 1.f);
        row_store_bf16(H + (size_t)r * 1024, lane, a);
    }
    xcd_barrier(bar);

#pragma unroll 1
    for (int l = 0; l < 2; ++l) {
        const bool last = (l == 1);
        const int Rl = last ? RL : RT;
        REFRESH();
        for (int it = bid; it < 136 * 21; it += G) {
            const int mt0 = it / 21, nt0 = it % 21;
            const int m0 = mt0 * 128, n0 = nt0 * 128;
            const int nrow = n0 + (tid >> 2);
            f32x4 acc[2][4];
            gemm_core<false>(ls, H + (size_t)(m0 + (tid >> 2)) * 1024 + (tid & 3) * 8, (nrow < NIN) ? WTM + WTM_WIN + (size_t)nrow * 1024 + (tid & 3) * 8 : nullptr, nullptr, 0, 1024, acc);
            EPI_IDS
#pragma unroll
            for (int nt = 0; nt < 2; ++nt)
#pragma unroll
                for (int mt = 0; mt < 4; ++mt) {
                    const int n = n0 + EPI_N(nt), m = m0 + EPI_M(mt);
                    if (n < NIN) { uint2 o; o.x = pack2(acc[nt][mt][0], acc[nt][mt][1]); o.y = pack2(acc[nt][mt][2], acc[nt][mt][3]); *(uint2*)(Z + (size_t)m * NIN + n) = o; }
                }
        }
        xcd_barrier(bar);
        REFRESH();
        for (int it = bid; it < 1088 + 2176; it += G) {
            if (it < 1088) mlstm_local_item(p, l, it, Z, MQ, MK, GL, CLOC, lf);
            else prep_row(p, l, (it - 1088) * 8 + wv, lane, Z, RR, RK, RV, KK, LI, LA, Kb, ROPE);
        }
        xcd_barrier(bar);
        REFRESH();
        for (int it = bid; it < 288 + 3264; it += G) {
            if (it < 288) { mlstm_scan_item(it, CLOC, lf); continue; }
            int gi = it - 288;
            EPI_IDS
            f32x4 acc[2][4];
            if (gi < 1088) {
                const int kind = gi / 272, t2 = gi % 272, m0 = (t2 >> 1) * 128, n0 = (t2 & 1) * 128, d = kind & 1;
                const u16* A = LI + (size_t)(m0 + (tid >> 2)) * 384 + (kind >> 1) * 128 + d * 64 + (tid & 3) * 8;
                const u16* B = WTM + ((kind >> 1) ? WTM_AUP : WTM_WUP) + (size_t)d * 256 * 64 + (size_t)(n0 + (tid >> 2)) * 64 + (tid & 3) * 8;
                gemm_core<false>(ls, A, B, nullptr, 0, 64, acc);
#pragma unroll
                for (int nt = 0; nt < 2; ++nt)
#pragma unroll
                    for (int mt = 0; mt < 4; ++mt) {
                        const int n = n0 + EPI_N(nt), m = m0 + EPI_M(mt);
                        if (kind < 2) {
                            const float4 w0 = *(const float4*)(p.in[11] + (l * 2 + d) * 256 + n);
                            float4 o;
                            o.x = __expf(-0.60653065971263342f * sigm(w0.x + acc[nt][mt][0])); o.y = __expf(-0.60653065971263342f * sigm(w0.y + acc[nt][mt][1]));
                            o.z = __expf(-0.60653065971263342f * sigm(w0.z + acc[nt][mt][2])); o.w = __expf(-0.60653065971263342f * sigm(w0.w + acc[nt][mt][3]));
                            *(float4*)(WD + ((size_t)d * RT + m) * 256 + n) = o;
                        } else {
                            const float4 a0 = *(const float4*)(p.in[13] + (l * 2 + d) * 256 + n);
                            const float4 ka = *(const float4*)(p.in[17] + l * 256 + n);
                            const uint2 kkv = *(const uint2*)(KK + (size_t)m * 256 + n), kv = *(const uint2*)(RK + (size_t)m * 256 + n);
                            const float a_0 = sigm(a0.x + acc[nt][mt][0]), a_1 = sigm(a0.y + acc[nt][mt][1]), a_2 = sigm(a0.z + acc[nt][mt][2]), a_3 = sigm(a0.w + acc[nt][mt][3]);
                            const float kk0 = __uint_as_float(kkv.x << 16), kk1 = __uint_as_float(kkv.x & 0xffff0000u), kk2 = __uint_as_float(kkv.y << 16), kk3 = __uint_as_float(kkv.y & 0xffff0000u);
                            const float k0 = __uint_as_float(kv.x << 16), k1 = __uint_as_float(kv.x & 0xffff0000u), k2 = __uint_as_float(kv.y << 16), k3 = __uint_as_float(kv.y & 0xffff0000u);
                            uint2 o1, o2;
                            o1.x = pack2(kk0 * a_0, kk1 * a_1); o1.y = pack2(kk2 * a_2, kk3 * a_3);
                            o2.x = pack2(k0 * (1.f + (a_0 - 1.f) * ka.x), k1 * (1.f + (a_1 - 1.f) * ka.y)); o2.y = pack2(k2 * (1.f + (a_2 - 1.f) * ka.z), k3 * (1.f + (a_3 - 1.f) * ka.w));
                            *(uint2*)(KKA + ((size_t)d * RT + m) * 256 + n) = o1;
                            *(uint2*)(KVEC + ((size_t)d * RT + m) * 256 + n) = o2;
                        }
                    }
                continue;
            }
            gi -= 1088;
            if (gi < 272) {
                const int m0 = (gi >> 1) * 128, n0 = (gi & 1) * 128;
                gemm_core<false>(ls, LI + (size_t)(m0 + (tid >> 2)) * 384 + 256 + (tid & 3) * 8, WTM + WTM_GUP + (size_t)(n0 + (tid >> 2)) * 128 + (tid & 3) * 8, nullptr, 0, 128, acc);
#pragma unroll
                for (int nt = 0; nt < 2; ++nt)
#pragma unroll
                    for (int mt = 0; mt < 4; ++mt) {
                        const int n = n0 + EPI_N(nt), m = m0 + EPI_M(mt);
                        uint2 o; o.x = pack2(acc[nt][mt][0], acc[nt][mt][1]); o.y = pack2(acc[nt][mt][2], acc[nt][mt][3]);
                        *(uint2*)(GG + (size_t)m * 256 + n) = o;
                    }
                continue;
            }
            gi -= 272;
            if (gi < 816) {
                const int m0 = (gi / 6) * 128, n0 = (gi % 6) * 128;
                gemm_core<false>(ls, LA + (size_t)(m0 + (tid >> 2)) * 384 + (tid & 3) * 8, WTM + WTM_UQ + (size_t)(n0 + (tid >> 2)) * 256 + (tid & 3) * 8, nullptr, 0, 256, acc);
#pragma unroll
                for (int nt = 0; nt < 2; ++nt)
#pragma unroll
                    for (int mt = 0; mt < 4; ++mt) {
                        const int n = n0 + EPI_N(nt), m = m0 + EPI_M(mt);
                        const RowInfo ri = row_info(m);
                        const int hh = n / 96, j = n % 96, idx = ri.isctx ? 4096 + ri.t : ri.t;
                        float x0 = acc[nt][mt][0], x1 = acc[nt][mt][1], x2 = acc[nt][mt][2], x3 = acc[nt][mt][3];
                        if (j >= 64 && !ri.isctx) {
                            const int pi = (j - 64) >> 1;
                            const float4 cs = *(const float4*)(ROPE + (ri.t * 16 + pi) * 2);
                            const float y0 = x0 * cs.x - x1 * cs.y, y1 = x0 * cs.y + x1 * cs.x, y2 = x2 * cs.z - x3 * cs.w, y3 = x2 * cs.w + x3 * cs.z;
                            x0 = y0; x1 = y1; x2 = y2; x3 = y3;
                        }
                        uint2 o; o.x = pack2(x0 * QSCALE, x1 * QSCALE); o.y = pack2(x2 * QSCALE, x3 * QSCALE);
                        *(uint2*)(Qb + ((size_t)(ri.b * 8 + hh) * NKEY + idx) * 96 + j) = o;
                    }
                continue;
            }
            gi -= 816;
            {
                const int m0 = (gi >> 3) * 128, n0 = (gi & 7) * 128;
                gemm_core<false>(ls, LA + (size_t)(m0 + (tid >> 2)) * 384 + 256 + (tid & 3) * 8, WTM + WTM_UKV + (size_t)(n0 + (tid >> 2)) * 128 + (tid & 3) * 8, nullptr, 0, 128, acc);
#pragma unroll
                for (int nt = 0; nt < 2; ++nt)
#pragma unroll
                    for (int mt = 0; mt < 4; ++mt) {
                        const int n = n0 + EPI_N(nt), m = m0 + EPI_M(mt);
                        const RowInfo ri = row_info(m);
                        const int hh = n >> 7, j = n & 127, idx = ri.isctx ? 4096 + ri.t : ri.t;
                        if (j < 64) {
                            uint2 o; o.x = pack2(acc[nt][mt][0], acc[nt][mt][1]); o.y = pack2(acc[nt][mt][2], acc[nt][mt][3]);
                            *(uint2*)(Kb + ((size_t)(ri.b * 8 + hh) * NKEY + idx) * 96 + j) = o;
                        } else {
                            u16* vt = VTb + ((size_t)(ri.b * 8 + hh) * 64 + (j - 64)) * NKEY + idx;
                            vt[0] = f2bf(acc[nt][mt][0]); vt[NKEY] = f2bf(acc[nt][mt][1]); vt[2 * NKEY] = f2bf(acc[nt][mt][2]); vt[3 * NKEY] = f2bf(acc[nt][mt][3]);
                        }
                    }
            }
        }
        xcd_barrier(bar);
        REFRESH();
        if (bid < 64) rwkv_scan_block(bid, WD, KK, KKA, KVEC, RR, RV, OFB, lf);
        {
            const int nAttL = 1024, nAttC = last ? 0 : 64, nMl = 1024, nMc = last ? 0 : 64;
            const int total = nAttL + nAttC + nMl + nMc;
            for (;;) {
                __syncthreads();
                if (tid == 0) misc[0] = (int)atomicAdd(&CTL[CW_QUEUE(l)], 1u);
                __syncthreads();
                int it = misc[0];
                if (it >= total) break;
                if (it < nAttL) { const int b = it >> 8, h = (it >> 5) & 7, qt = it & 31; attn_item(b, h, qt * 128, 0, 68, b * 4096 + qt * 128, Qb, Kb, VTb, MIX, ls); continue; }
                it -= nAttL;
                if (it < nAttC) { const int b = it >> 4, h = (it >> 1) & 7, qt = it & 1; attn_item(b, h, 4096 + qt * 128, 4096, 4, RL + b * 256 + qt * 128, Qb, Kb, VTb, MIX, ls); continue; }
                it -= nAttC;
                if (it < nMl) { const int b = it >> 8, h = (it >> 6) & 3, tb = 4 + (it & 63); mlstm_out_item(p, l, b, h, tb, Z, MQ, MK, GL, CLOC, MIX, lf); continue; }
                it -= nMl;
                { const int b = it >> 4, h = (it >> 2) & 3, tb = it & 3; mlstm_out_item(p, l, b, h, tb, Z, MQ, MK, GL, CLOC, MIX, lf); }
            }
        }
        xcd_barrier(bar);
        REFRESH();
        for (int r = bid * 8 + wv; r < Rl; r += G * 8) {
#pragma unroll
            for (int hh = 0; hh < 4; ++hh) {
                const int c = hh * 64 + lane;
                const float o = OFB[(size_t)r * 256 + c] + OFB[((size_t)RT + r) * 256 + c];
                const float mean = wave_sum(o) * (1.f / 64.f);
                const float dd = o - mean;
                const float rstd = rsqrtf(wave_sum(dd * dd) * (1.f / 64.f) + 64e-5f);
                const float rv = bf2f(RR[(size_t)r * 256 + c]);
                const float bs = wave_sum(rv * p.in[18][l * 256 + c] * (bf2f(KVEC[(size_t)r * 256 + c]) + bf2f(KVEC[((size_t)RT + r) * 256 + c])));
                const float hn = dd * rstd * p.in[19][l * 256 + c] + p.in[20][l * 256 + c] + bs * bf2f(RV[(size_t)r * 256 + c]);
                MIX[(size_t)r * 1024 + 256 + c] = f2bf(hn * bf2f(GG[(size_t)r * 256 + c]));
            }
        }
        xcd_barrier(bar);
        REFRESH();
        for (int it = bid; it < (Rl / 128) * 8; it += G) {
            const int m0 = (it >> 3) * 128, n0 = (it & 7) * 128;
            f32x4 acc[2][4];
            gemm_core<false>(ls, MIX + (size_t)(m0 + (tid >> 2)) * 1024 + (tid & 3) * 8, WTM + WTM_WOUT + (size_t)(n0 + (tid >> 2)) * 1024 + (tid & 3) * 8, nullptr, 0, 1024, acc);
            EPI_IDS
#pragma unroll
            for (int nt = 0; nt < 2; ++nt)
#pragma unroll
                for (int mt = 0; mt < 4; ++mt) {
                    const int n = n0 + EPI_N(nt), m = m0 + EPI_M(mt);
                    *(float4*)(Y + (size_t)m * 1024 + n) = make_float4(acc[nt][mt][0], acc[nt][mt][1], acc[nt][mt][2], acc[nt][mt][3]);
                }
        }
        xcd_barrier(bar);
        REFRESH();
        {
            const int rpb = (Rl + G - 1) / G;
            const int r0 = bid * rpb, r1 = min(Rl, r0 + rpb);
            int* lcnt = (int*)(lds + 40960);
            int* lbase = lcnt + 64;
            int* srec = lbase + 64;
            int* srec_e = srec;
            int* srec_p = srec + 1024;
            float* srec_g = (float*)(srec + 2048);
            float* hrow = lf + wv * 1024;
            if (tid < 64) lcnt[tid] = 0;
            __syncthreads();
            for (int r = r0 + wv; r < r1; r += 8) {
                const RowInfo ri = row_info(r);
                const float* xr = (l == 0) ? (ri.isctx ? ctx_in + (size_t)(r - RL) * 1024 : x_in + (size_t)r * 1024) : (ri.isctx ? XC + (size_t)(r - RL) * 1024 : OUT + (size_t)r * 1024);
                float* xw = ri.isctx ? XC + (size_t)(r - RL) * 1024 : OUT + (size_t)r * 1024;
                const float* md = MOD + (l * 5 + ri.mi) * 6144;
                float4 a[4], y[4]; row_load(xr, lane, a); row_load(Y + (size_t)r * 1024, lane, y);
#pragma unroll
                for (int i = 0; i < 4; ++i) {
                    const float4 gt = *(const float4*)(md + 2048 + (i * 64 + lane) * 4);
                    a[i].x = ALPHA * a[i].x + gt.x * y[i].x; a[i].y = ALPHA * a[i].y + gt.y * y[i].y; a[i].z = ALPHA * a[i].z + gt.z * y[i].z; a[i].w = ALPHA * a[i].w + gt.w * y[i].w;
                }
                row_ln(a); row_affine(a, p.in[26] + l * 1024, p.in[27] + l * 1024, lane, 0.f);
                row_store_f32(xw, lane, a);
                row_ln(a); row_affine(a, md + 4096, md + 3072, lane, 1.f);
                row_store_bf16(H + (size_t)r * 1024, lane, a);
                row_store_f32(hrow, lane, a);
                const float* rw = p.in[28] + (size_t)l * 1024 * 64 + lane;
                float lg = 0.f;
                for (int k = 0; k < 1024; k += 4) {
                    const float4 hv = *(const float4*)(hrow + k);
                    lg += hv.x * rw[(size_t)(k + 0) * 64] + hv.y * rw[(size_t)(k + 1) * 64] + hv.z * rw[(size_t)(k + 2) * 64] + hv.w * rw[(size_t)(k + 3) * 64];
                }
                const float score = sigm(lg), biased = score + p.in[29][l * 64 + lane];
                float m1 = biased; m1 = fmaxf(m1, __shfl_xor(m1, 1)); m1 = fmaxf(m1, __shfl_xor(m1, 2)); m1 = fmaxf(m1, __shfl_xor(m1, 4));
                const unsigned long long eq = __ballot(biased == m1);
                const int grp = lane >> 3;
                const int idx1 = __builtin_ctz((unsigned)((eq >> (grp * 8)) & 0xffull));
                float v2 = ((lane & 7) == idx1) ? -INFINITY : biased;
                v2 = fmaxf(v2, __shfl_xor(v2, 1)); v2 = fmaxf(v2, __shfl_xor(v2, 2)); v2 = fmaxf(v2, __shfl_xor(v2, 4));
                const float gs = m1 + v2;
                int grank = 0;
#pragma unroll
                for (int j = 0; j < 8; ++j) { const float gj = __shfl(gs, j * 8); grank += (gj > gs || (gj == gs && j < grp)) ? 1 : 0; }
                const float masked = (grank < 4) ? biased : -INFINITY;
                int rank = 0;
                for (int j = 0; j < 64; ++j) { const float vj = __shfl(masked, j); rank += (vj > masked || (vj == masked && j < lane)) ? 1 : 0; }
                const bool sel = rank < 8;
                const float ssum = wave_sum(sel ? score : 0.f);
                if (sel) {
                    const int lp = atomicAdd(&lcnt[lane], 1);
                    const int rl = r - r0;
                    srec_e[rl * 8 + rank] = lane; srec_p[rl * 8 + rank] = lp; srec_g[rl * 8 + rank] = 2.5f * score / ssum;
                }
            }
            __syncthreads();
            if (tid < 64) lbase[tid] = (int)atomicAdd(&CTL[CW_CNT(l) + tid], (unsigned)lcnt[tid]);
            __syncthreads();
            for (int i = tid; i < (r1 - r0) * 8; i += 512) {
                const int e = srec_e[i], pos = lbase[e] + srec_p[i], r = r0 + (i >> 3);
                TOK[(size_t)e * RT + pos] = r; GATE[(size_t)e * RT + pos] = srec_g[i]; SLOT[(size_t)r * 8 + (i & 7)] = (e << 20) | pos;
            }
            __syncthreads();
            for (int it = bid; it < N_CONV_MOE; it += G) conv_moe_item(p, l, it, WTE, ls);
        }
        xcd_barrier(bar);
        REFRESH();
        {
            int* pre = (int*)(lds + LDS_BYTES - 1024);
            if (tid == 0) {
                int a = 0, o = 0;
                for (int e = 0; e < 64; ++e) { const int c = (int)CTL[CW_CNT(l) + e]; pre[e] = a; pre[66 + e] = o; a += (c + 127) >> 7; o += c; }
                pre[64] = a; pre[66 + 64] = SH_SLOT; a += Rl / 128; pre[65] = a;
            }
            __syncthreads();
            const int nitems = pre[65];
            u16* Act = ls + 2 * STG_BUF;
            for (int it = bid; it < nitems; it += G) {
                int e = 0;
                while (pre[e + 1] <= it) ++e;
                const int mtile = it - pre[e];
                const int cnt = (e < 64) ? (int)CTL[CW_CNT(l) + e] : Rl;
                const int nvalid = min(128, cnt - mtile * 128);
                const int slot0 = pre[66 + e] + mtile * 128;
                const int arow = tid >> 2;
                int tokr = -1;
                if (arow < nvalid) tokr = (e < 64) ? TOK[(size_t)e * RT + mtile * 128 + arow] : mtile * 128 + arow;
                const u16* pa = (tokr >= 0) ? H + (size_t)tokr * 1024 + (tid & 3) * 8 : nullptr;
                const u16* w1 = WTE + (size_t)e * WTE_PER; const u16* w2 = w1 + 512 * 1024;
                EPI_IDS
                f32x4 acc[2][4];
#pragma unroll 1
                for (int n4 = 0; n4 < 4; ++n4) {
                    gemm_core<false>(ls, pa, w1 + (size_t)(n4 * 128 + (tid >> 2)) * 1024 + (tid & 3) * 8, nullptr, 0, 1024, acc);
#pragma unroll
                    for (int mt = 0; mt < 4; ++mt) {
                        const int m = EPI_M(mt), col = (n4 * 4 + wn) * 16 + 4 * g;
                        float a0 = acc[0][mt][0], a1 = acc[0][mt][1], a2 = acc[0][mt][2], a3 = acc[0][mt][3];
                        a0 = a0 / (1.f + __expf(-a0)) * acc[1][mt][0]; a1 = a1 / (1.f + __expf(-a1)) * acc[1][mt][1];
                        a2 = a2 / (1.f + __expf(-a2)) * acc[1][mt][2]; a3 = a3 / (1.f + __expf(-a3)) * acc[1][mt][3];
                        uint2 o; o.x = pack2(a0, a1); o.y = pack2(a2, a3);
                        *(uint2*)(Act + m * 264 + col) = o;
                    }
                }
                __syncthreads();
#pragma unroll 1
                for (int n8 = 0; n8 < 8; ++n8) {
                    gemm_core<true>(ls, nullptr, w2 + (size_t)(n8 * 128 + (tid >> 2)) * 256 + (tid & 3) * 8, Act, 264, 256, acc);
#pragma unroll
                    for (int mt = 0; mt < 4; ++mt) {
                        const int m = EPI_M(mt);
                        if (m < nvalid) {
                            const float gt = (e < 64) ? GATE[(size_t)e * RT + mtile * 128 + m] : 1.f;
#pragma unroll
                            for (int nt = 0; nt < 2; ++nt) {
                                const int n = n8 * 128 + EPI_N(nt);
                                uint2 o; o.x = pack2(acc[nt][mt][0] * gt, acc[nt][mt][1] * gt); o.y = pack2(acc[nt][mt][2] * gt, acc[nt][mt][3] * gt);
                                *(uint2*)(YEXP + (size_t)(slot0 + m) * 1024 + n) = o;
                            }
                        }
                    }
                }
                __syncthreads();
            }
        }
        xcd_barrier(bar);
        REFRESH();
        {
            int* off = (int*)(lds + LDS_BYTES - 1024);
            if (tid == 0) { int o = 0; for (int e = 0; e < 64; ++e) { off[e] = o; o += (int)CTL[CW_CNT(l) + e]; } }
            __syncthreads();
            for (int r = bid * 8 + wv; r < Rl; r += G * 8) {
                const RowInfo ri = row_info(r);
                float* xw = ri.isctx ? XC + (size_t)(r - RL) * 1024 : OUT + (size_t)r * 1024;
                const float* md = MOD + (l * 5 + ri.mi) * 6144;
                float4 f[4];
#pragma unroll
                for (int i = 0; i < 4; ++i) f[i] = make_float4(0.f, 0.f, 0.f, 0.f);
#pragma unroll 1
                for (int j = 0; j < 9; ++j) {
                    int slot;
                    if (j < 8) { const int sv = SLOT[(size_t)r * 8 + j]; slot = off[sv >> 20] + (sv & 0xfffff); } else slot = SH_SLOT + r;
                    const u16* yr = YEXP + (size_t)slot * 1024;
#pragma unroll
                    for (int i = 0; i < 4; ++i) {
                        const uint2 v = *(const uint2*)(yr + (i * 64 + lane) * 4);
                        f[i].x += __uint_as_float(v.x << 16); f[i].y += __uint_as_float(v.x & 0xffff0000u); f[i].z += __uint_as_float(v.y << 16); f[i].w += __uint_as_float(v.y & 0xffff0000u);
                    }
                }
                float4 a[4]; row_load(xw, lane, a);
#pragma unroll
                for (int i = 0; i < 4; ++i) {
                    const float4 gt = *(const float4*)(md + 5120 + (i * 64 + lane) * 4);
                    a[i].x = ALPHA * a[i].x + gt.x * f[i].x; a[i].y = ALPHA * a[i].y + gt.y * f[i].y; a[i].z = ALPHA * a[i].z + gt.z * f[i].z; a[i].w = ALPHA * a[i].w + gt.w * f[i].w;
                }
                row_ln(a); row_affine(a, p.in[36] + l * 1024, p.in[37] + l * 1024, lane, 0.f);
                row_store_f32(xw, lane, a);
                if (!last) {
                    const float* md2 = MOD + ((l + 1) * 5 + ri.mi) * 6144;
                    row_ln(a); row_affine(a, md2 + 1024, md2, lane, 1.f);
                    row_store_bf16(H + (size_t)r * 1024, lane, a);
                }
            }
            if (!last) for (int it = bid; it < N_CONV_MIXER; it += G) conv_mixer_item(p, l + 1, it, WTM, ls);
            __syncthreads();
        }
        if (!last) xcd_barrier(bar);
    }
}

extern "C" void kernel_launch(void* const* d_in, const int* in_sizes, int n_in, void* d_out, int out_size, void* d_ws, size_t ws_size, hipStream_t stream) {
    static int grid = 0;
    if (grid == 0) {
        int dev = 0, cus = 0, per_cu = 0;
        hipGetDevice(&dev);
        hipDeviceGetAttribute(&cus, hipDeviceAttributeMultiprocessorCount, dev);
        hipOccupancyMaxActiveBlocksPerMultiprocessor(&per_cu, (const void*)mega, 512, 0);
        (void)hipGetLastError();
        grid = (per_cu >= 1 && cus >= 256) ? 256 : -1;
        if (n_in != 38 || ws_size < WS_NEED) grid = -1;
        if (grid < 0) fprintf(stderr, "kernel_launch: cannot run (cus %d, per_cu %d, n_in %d, ws %zu need %zu)\n", cus, per_cu, n_in, ws_size, (size_t)WS_NEED);
    }
    if (grid < 0) return;
    hipMemsetAsync((char*)d_ws + OFF_CTL, 0, 65536, stream);
    Params p{};
    for (int i = 0; i < 38; ++i) p.in[i] = (const float*)d_in[i];
    p.out = (float*)d_out; p.ws = (unsigned char*)d_ws;
    hipLaunchKernelGGL(mega, dim3(grid), dim3(512), 0, stream, p);
}
```

```cpp
#include <hip/hip_runtime.h>
#include <stdint.h>
#include <stdio.h>

typedef unsigned short u16;
typedef __attribute__((ext_vector_type(8))) short bf16x8;
typedef __attribute__((ext_vector_type(4))) float f32x4;
#define DEVI __device__ __forceinline__
#define LAS __attribute__((address_space(3)))

#define DM 1024
#define TL 4096
#define TC 256
#define RL 16384
#define RT 17408
#define NIN 2608
#define ZC_MV 512
#define ZC_MO 768
#define ZC_MG 1024
#define ZC_RW 1040
#define ZC_MLA 2192
#define NKEY 4352
#define ALPHA 1.41421356237309515f
#define QSCALE (0.10206207261596575f * 1.4426950408889634f)
#define CREC 4224
#define SH_SLOT 139264

constexpr size_t OFF_CTL  = 0;
constexpr size_t OFF_MOD  = 65536;
constexpr size_t OFF_ROPE = OFF_MOD + 245760;
constexpr size_t OFF_XC   = OFF_ROPE + 524288;
constexpr size_t OFF_WTM  = OFF_XC + 4194304;
constexpr size_t WTM_WIN = 0, WTM_UQ = WTM_WIN + (size_t)2816 * 1024, WTM_UKV = WTM_UQ + 768 * 256, WTM_WUP = WTM_UKV + 1024 * 128,
                 WTM_AUP = WTM_WUP + 2 * 256 * 64, WTM_GUP = WTM_AUP + 2 * 256 * 64, WTM_WOUT = WTM_GUP + 256 * 128, WTM_END = WTM_WOUT + 1024 * 1024;
constexpr size_t OFF_H    = OFF_WTM + ((WTM_END * 2 + 255) & ~(size_t)255);
constexpr size_t OFF_S    = OFF_H + (size_t)RT * 1024 * 2;
constexpr size_t S_Z    = OFF_S;
constexpr size_t S_MQ   = S_Z + (size_t)RT * NIN * 2;
constexpr size_t S_MK   = S_MQ + (size_t)RT * 256 * 2;
constexpr size_t S_GL   = S_MK + (size_t)RT * 256 * 2;
constexpr size_t S_CLOC = S_GL + (size_t)RT * 16 * 4;
constexpr size_t S_WD   = S_CLOC + (size_t)32 * 68 * CREC * 4;
constexpr size_t S_KK   = S_WD + (size_t)2 * RT * 256 * 4;
constexpr size_t S_KKA  = S_KK + (size_t)RT * 256 * 2;
constexpr size_t S_KVEC = S_KKA + (size_t)2 * RT * 256 * 2;
constexpr size_t S_RR   = S_KVEC + (size_t)2 * RT * 256 * 2;
constexpr size_t S_RV   = S_RR + (size_t)RT * 256 * 2;
constexpr size_t S_RK   = S_RV + (size_t)RT * 256 * 2;
constexpr size_t S_G    = S_RK + (size_t)RT * 256 * 2;
constexpr size_t S_LI   = S_G + (size_t)RT * 256 * 2;
constexpr size_t S_LA   = S_LI + (size_t)RT * 384 * 2;
constexpr size_t S_OF   = S_LA + (size_t)RT * 384 * 2;
constexpr size_t S_Q    = S_OF + (size_t)2 * RT * 256 * 4;
constexpr size_t S_K    = S_Q + (size_t)32 * NKEY * 96 * 2;
constexpr size_t S_VT   = S_K + (size_t)32 * NKEY * 96 * 2;
constexpr size_t S_MIX_END = S_VT + (size_t)32 * 64 * NKEY * 2;
constexpr size_t S_YEXP = OFF_S;
constexpr size_t S_Y    = OFF_S;
constexpr size_t S_WTE  = S_YEXP + (size_t)(SH_SLOT + RT) * 1024 * 2;
constexpr size_t WTE_PER = 786432;
constexpr size_t S_TOK  = S_WTE + (size_t)65 * WTE_PER * 2;
constexpr size_t S_GATE = S_TOK + (size_t)64 * RT * 4;
constexpr size_t S_SLOT = S_GATE + (size_t)64 * RT * 4;
constexpr size_t S_ACT  = S_SLOT + (size_t)RT * 8 * 4;
constexpr size_t S_MOE_END = S_ACT + (size_t)(SH_SLOT + RT) * 256 * 2;
constexpr size_t WS_NEED = (S_MIX_END > S_MOE_END ? S_MIX_END : S_MOE_END);

#define CW_QUEUE(l) (4096 + 64 * (l))
#define CW_CNT(l)   (4352 + 64 * (l))
#define LDS_BYTES 139264

#ifndef PROF
#define PROF 0
#endif
#ifndef PROF_A
#define PROF_A 0
#endif
#ifndef PROF_B
#define PROF_B 1
#endif
#define CW_TS 8192
struct Params { const float* in[38]; float* out; unsigned char* ws; };

typedef const float* KArgPtr;
DEVI const float* pin_(int i) {
    const __attribute__((address_space(4))) KArgPtr* tab = (const __attribute__((address_space(4))) KArgPtr*)__builtin_amdgcn_kernarg_segment_ptr();
    asm volatile("" : "+s"(i));
    return tab[i];
}
#define PIN(i) pin_(i)
DEVI int TID() { int t = threadIdx.x; asm volatile("" : "+v"(t)); return t; }
DEVI float bf2f(u16 v) { return __uint_as_float(((unsigned)v) << 16); }
DEVI u16 f2bf(float f) { unsigned u = __float_as_uint(f); u += 0x7fffu + ((u >> 16) & 1u); return (u16)(u >> 16); }
typedef float f32x2_t __attribute__((ext_vector_type(2)));
typedef __bf16 bf16x2_t __attribute__((ext_vector_type(2)));
DEVI unsigned pack2(float a, float b) { f32x2_t v = {a, b}; bf16x2_t r = __builtin_convertvector(v, bf16x2_t); return __builtin_bit_cast(unsigned, r); }
DEVI float xrow16_max(float x) {
    auto s = __builtin_amdgcn_permlane16_swap(__float_as_uint(x), __float_as_uint(x), false, false);
    x = fmaxf(__uint_as_float(s[0]), __uint_as_float(s[1]));
    auto t = __builtin_amdgcn_permlane32_swap(__float_as_uint(x), __float_as_uint(x), false, false);
    return fmaxf(__uint_as_float(t[0]), __uint_as_float(t[1]));
}
DEVI float xrow16_sum(float x) {
    auto s = __builtin_amdgcn_permlane16_swap(__float_as_uint(x), __float_as_uint(x), false, false);
    x = __uint_as_float(s[0]) + __uint_as_float(s[1]);
    auto t = __builtin_amdgcn_permlane32_swap(__float_as_uint(x), __float_as_uint(x), false, false);
    return __uint_as_float(t[0]) + __uint_as_float(t[1]);
}
DEVI float wave_sum(float v) {
#pragma unroll
    for (int o = 32; o > 0; o >>= 1) v += __shfl_xor(v, o);
    return v;
}
DEVI float wave_max(float v) {
#pragma unroll
    for (int o = 32; o > 0; o >>= 1) v = fmaxf(v, __shfl_xor(v, o));
    return v;
}
DEVI float sigm(float x) { return 1.f / (1.f + __expf(-x)); }
DEVI float logsig(float x) { return fminf(x, 0.f) - __logf(1.f + __expf(-fabsf(x))); }
DEVI float tanh_(float x) { const float e = __expf(2.f * x); return 1.f - 2.f / (e + 1.f); }
template <int CTRL> DEVI float dpp_f(float x) { return __builtin_bit_cast(float, __builtin_amdgcn_update_dpp(0, __builtin_bit_cast(int, x), CTRL, 0xf, 0xf, false)); }
DEVI float red16(float x) {
    x += dpp_f<0xB1>(x); x += dpp_f<0x4E>(x); x += dpp_f<0x141>(x); x += dpp_f<0x140>(x); return x;
}

#define XB_TMO      128
#define XB_XCNT(j)  (256  + 64 * (j))
#define XB_XSUB(j)  (1280 + 64 * (j))
#define XB_XGEN(j)  (2304 + 64 * (j))
#define XB_TOP      3328
#define XB_TOPGEN   3392
#define XB_SPIN_CAP (1u << 27)
DEVI unsigned xb_ld(unsigned* p) { return __hip_atomic_load(p, __ATOMIC_RELAXED, __HIP_MEMORY_SCOPE_AGENT); }
DEVI unsigned xb_add(unsigned* p, unsigned v) { return __hip_atomic_fetch_add(p, v, __ATOMIC_RELAXED, __HIP_MEMORY_SCOPE_AGENT); }
DEVI unsigned xb_xcc_id() { return (unsigned)__builtin_amdgcn_s_getreg((3 << 11) | 20) & 0xFu; }
#define XB_SPIN(cond, bar) do { unsigned _sp = 0; while (cond) { __builtin_amdgcn_s_sleep(2); \
    if ((++_sp & 1023u) == 0u) { if (xb_ld(&(bar)[XB_TMO])) break; if (_sp > XB_SPIN_CAP) { atomicAdd(&(bar)[XB_TMO], 1u); break; } } } } while (0)
struct XcdBarrier { unsigned* bar; unsigned x; volatile LAS unsigned* st; };
DEVI XcdBarrier xcd_barrier_post(unsigned* bar, volatile LAS unsigned* st) {
    XcdBarrier b; b.bar = bar; b.x = 0; b.st = st;
    if (threadIdx.x == 0) { const unsigned x = xb_xcc_id(); st[2] = x; (void)xb_add(&bar[XB_XCNT(x)], 1u); }
    return b;
}
DEVI void xcd_barrier_complete(unsigned* bar, unsigned x, unsigned& nloc, unsigned& nx) {
    const unsigned G = gridDim.x;
    unsigned sum, cnt, mine, sp = 0u;
    for (;;) {
        sum = 0u; cnt = 0u; mine = 0u;
#pragma unroll
        for (unsigned j = 0; j < 16; ++j) { const unsigned c = xb_ld(&bar[XB_XCNT(j)]); sum += c; cnt += (c > 0u) ? 1u : 0u; mine = (j == x) ? c : mine; }
        if (sum == G) break;
        __builtin_amdgcn_s_sleep(2);
        if ((++sp & 1023u) == 0u) { if (xb_ld(&bar[XB_TMO])) break; if (sp > XB_SPIN_CAP) { atomicAdd(&bar[XB_TMO], 1u); break; } }
    }
    nloc = mine > 0u ? mine : 1u; nx = cnt > 0u ? cnt : 1u;
}
DEVI void xcd_barrier(const XcdBarrier& b) {
    asm volatile("s_waitcnt vmcnt(0)" ::: "memory");
    __syncthreads();
    if (threadIdx.x == 0) {
        unsigned* bar = b.bar;
        __builtin_amdgcn_s_waitcnt(0);
        unsigned nloc = b.st[0], nx = b.st[1];
        const unsigned bx = b.st[2];
        if (nloc == 0u) { xcd_barrier_complete(bar, bx, nloc, nx); b.st[0] = nloc; b.st[1] = nx; }
        const unsigned old = xb_add(&bar[XB_XSUB(bx)], 1u);
        const unsigned gen = old / nloc;
        if (old + 1u == (gen + 1u) * nloc) {
            __builtin_amdgcn_fence(__ATOMIC_RELEASE, "agent");
            asm volatile("s_waitcnt vmcnt(0)" ::: "memory");
            const unsigned og = xb_add(&bar[XB_TOP], 1u);
            const unsigned tg = og / nx;
            if (og + 1u == (tg + 1u) * nx) xb_add(&bar[XB_TOPGEN], 1u);
            else XB_SPIN(xb_ld(&bar[XB_TOPGEN]) == tg, bar);
            __builtin_amdgcn_fence(__ATOMIC_ACQUIRE, "agent");
            xb_add(&bar[XB_XGEN(bx)], 1u);
            asm volatile("s_waitcnt vmcnt(0)" ::: "memory");
        } else {
            XB_SPIN(xb_ld(&bar[XB_XGEN(bx)]) == gen, bar);
            __builtin_amdgcn_fence(__ATOMIC_ACQUIRE, "agent");
            asm volatile("s_waitcnt vmcnt(0)" ::: "memory");
        }
    }
    __syncthreads();
}

struct RowInfo { int b, t, seglen, isctx, mi; };
DEVI RowInfo row_info(int r) {
    RowInfo ri;
    if (r < RL) { ri.b = r >> 12; ri.t = r & 4095; ri.seglen = TL; ri.isctx = 0; ri.mi = ri.b; }
    else { int q = r - RL; ri.b = q >> 8; ri.t = q & 255; ri.seglen = TC; ri.isctx = 1; ri.mi = 4; }
    return ri;
}
DEVI void row_load(const float* row, int lane, float4 (&a)[4]) {
#pragma unroll
    for (int i = 0; i < 4; ++i) a[i] = *(const float4*)(row + (i * 64 + lane) * 4);
}
DEVI void row_ln(float4 (&a)[4]) {
    float s = 0.f;
#pragma unroll
    for (int i = 0; i < 4; ++i) s += a[i].x + a[i].y + a[i].z + a[i].w;
    const float mean = wave_sum(s) * (1.f / 1024.f);
    float q = 0.f;
#pragma unroll
    for (int i = 0; i < 4; ++i) { a[i].x -= mean; a[i].y -= mean; a[i].z -= mean; a[i].w -= mean; q += a[i].x * a[i].x + a[i].y * a[i].y + a[i].z * a[i].z + a[i].w * a[i].w; }
    const float rstd = rsqrtf(wave_sum(q) * (1.f / 1024.f) + 1e-6f);
#pragma unroll
    for (int i = 0; i < 4; ++i) { a[i].x *= rstd; a[i].y *= rstd; a[i].z *= rstd; a[i].w *= rstd; }
}
DEVI void row_affine(float4 (&a)[4], const float* mul, const float* add, int lane, float mul_plus) {
#pragma unroll
    for (int i = 0; i < 4; ++i) {
        const float4 m = *(const float4*)(mul + (i * 64 + lane) * 4), d = *(const float4*)(add + (i * 64 + lane) * 4);
        a[i].x = a[i].x * (m.x + mul_plus) + d.x; a[i].y = a[i].y * (m.y + mul_plus) + d.y; a[i].z = a[i].z * (m.z + mul_plus) + d.z; a[i].w = a[i].w * (m.w + mul_plus) + d.w;
    }
}
DEVI void row_store_bf16(u16* row, int lane, const float4 (&a)[4]) {
#pragma unroll
    for (int i = 0; i < 4; ++i) { uint2 o; o.x = pack2(a[i].x, a[i].y); o.y = pack2(a[i].z, a[i].w); *(uint2*)(row + (i * 64 + lane) * 4) = o; }
}
DEVI void row_store_f32(float* row, int lane, const float4 (&a)[4]) {
#pragma unroll
    for (int i = 0; i < 4; ++i) *(float4*)(row + (i * 64 + lane) * 4) = a[i];
}

#define STG_A 0
#define STG_B 5120
#define STG_BUF 10240
template <bool A_LDS>
DEVI void gemm_core(u16* stage, const u16* pa, const u16* pb, const u16* aLds, int aStride, int K, f32x4 (&acc)[2][4]) {
    const int tid = TID(), lane = tid & 63, w = tid >> 6, wm = w >> 2, wn = w & 3, g = lane >> 4, li = lane & 15;
    const int ldrow = tid >> 2, ldseg = tid & 3;
#pragma unroll
    for (int nt = 0; nt < 2; ++nt)
#pragma unroll
        for (int mt = 0; mt < 4; ++mt) acc[nt][mt] = (f32x4){0.f, 0.f, 0.f, 0.f};
    uint4 ra = make_uint4(0, 0, 0, 0), rb = make_uint4(0, 0, 0, 0);
    if (!A_LDS) { if (pa) ra = *(const uint4*)(pa); }
    if (pb) rb = *(const uint4*)(pb);
    if (!A_LDS) *(uint4*)(stage + STG_A + ldrow * 40 + ldseg * 8) = ra;
    *(uint4*)(stage + STG_B + ldrow * 40 + ldseg * 8) = rb;
    __syncthreads();
    const int nk = K >> 5;
    for (int kt = 0; kt < nk; ++kt) {
        const int bsel = kt & 1;
        if (kt + 1 < nk) {
            if (!A_LDS) { if (pa) ra = *(const uint4*)(pa + (kt + 1) * 32); }
            if (pb) rb = *(const uint4*)(pb + (kt + 1) * 32);
        }
        const u16* As = A_LDS ? (aLds + kt * 32) : (stage + bsel * STG_BUF + STG_A);
        const int as = A_LDS ? aStride : 40;
        const u16* Bs = stage + bsel * STG_BUF + STG_B;
        bf16x8 af[4], bfr[2];
#pragma unroll
        for (int mt = 0; mt < 4; ++mt) af[mt] = *(const bf16x8*)(As + (wm * 64 + mt * 16 + li) * as + g * 8);
#pragma unroll
        for (int nt = 0; nt < 2; ++nt) bfr[nt] = *(const bf16x8*)(Bs + (wn * 32 + nt * 16 + li) * 40 + g * 8);
#pragma unroll
        for (int nt = 0; nt < 2; ++nt)
#pragma unroll
            for (int mt = 0; mt < 4; ++mt) acc[nt][mt] = __builtin_amdgcn_mfma_f32_16x16x32_bf16(bfr[nt], af[mt], acc[nt][mt], 0, 0, 0);
        if (kt + 1 < nk) {
            if (!A_LDS) *(uint4*)(stage + (bsel ^ 1) * STG_BUF + STG_A + ldrow * 40 + ldseg * 8) = ra;
            *(uint4*)(stage + (bsel ^ 1) * STG_BUF + STG_B + ldrow * 40 + ldseg * 8) = rb;
        }
        __syncthreads();
    }
}
#define EPI_M(mt) (wm * 64 + (mt) * 16 + li)
#define EPI_N(nt) (wn * 32 + (nt) * 16 + 4 * g)
#define EPI_IDS const int tid = TID(), lane = tid & 63, w = tid >> 6, wm = w >> 2, wn = w & 3, g = lane >> 4, li = lane & 15; (void)lane;

DEVI void conv_tile(const float* src, int ldn, int K, int N, u16* dst, int rb, int rs16, int tk, int tn, u16* t) {
    const int k0 = tk * 64, n0 = tn * 64, tid = TID();
    const int kr = tid >> 4, nc = (tid & 15) * 4;
#pragma unroll
    for (int hh = 0; hh < 2; ++hh) {
        const int k = k0 + kr + hh * 32;
        float4 v = make_float4(0.f, 0.f, 0.f, 0.f);
        if (n0 + nc < N) v = *(const float4*)(src + (size_t)k * ldn + n0 + nc);
        t[(nc + 0) * 72 + kr + hh * 32] = f2bf(v.x); t[(nc + 1) * 72 + kr + hh * 32] = f2bf(v.y);
        t[(nc + 2) * 72 + kr + hh * 32] = f2bf(v.z); t[(nc + 3) * 72 + kr + hh * 32] = f2bf(v.w);
    }
    __syncthreads();
    const int n = tid >> 3, ks = (tid & 7) * 8;
    if (n0 + n < N) {
        const uint4 o = *(const uint4*)(t + n * 72 + ks);
        const int nn = n0 + n, row = rb + (nn >> 4) * rs16 + (nn & 15);
        *(uint4*)(dst + (size_t)row * K + k0 + ks) = o;
    }
    __syncthreads();
}
DEVI void conv_mixer_item(const Params& p, int l, int it, u16* wtm, u16* t) {
    if (it < 656) { conv_tile(PIN(6) + (size_t)l * 1024 * NIN, NIN, 1024, NIN, wtm + WTM_WIN, 0, 16, it / 41, it % 41, t); return; }
    it -= 656;
    if (it < 48) { conv_tile(PIN(23) + (size_t)l * 256 * 768, 768, 256, 768, wtm + WTM_UQ, 0, 16, it / 12, it % 12, t); return; }
    it -= 48;
    if (it < 32) { conv_tile(PIN(24) + (size_t)l * 128 * 1024, 1024, 128, 1024, wtm + WTM_UKV, 0, 16, it / 16, it % 16, t); return; }
    it -= 32;
    if (it < 8) { const int d = it >> 2; conv_tile(PIN(12) + (size_t)(l * 2 + d) * 64 * 256, 256, 64, 256, wtm + WTM_WUP + d * 256 * 64, 0, 16, 0, it & 3, t); return; }
    it -= 8;
    if (it < 8) { const int d = it >> 2; conv_tile(PIN(14) + (size_t)(l * 2 + d) * 64 * 256, 256, 64, 256, wtm + WTM_AUP + d * 256 * 64, 0, 16, 0, it & 3, t); return; }
    it -= 8;
    if (it < 8) { conv_tile(PIN(15) + (size_t)l * 128 * 256, 256, 128, 256, wtm + WTM_GUP, 0, 16, it >> 2, it & 3, t); return; }
    it -= 8;
    conv_tile(PIN(25) + (size_t)l * 1024 * 1024, 1024, 1024, 1024, wtm + WTM_WOUT, 0, 16, it >> 4, it & 15, t);
}
#define N_CONV_MIXER 1016
DEVI void conv_moe_item(const Params& p, int l, int it, u16* wte, u16* t) {
    const int e = it / 192, r = it % 192;
    u16* w1 = wte + (size_t)e * WTE_PER; u16* w2 = w1 + 512 * 1024;
    if (r < 64) {
        const float* src = (e < 64) ? PIN(30) + (size_t)(l * 64 + e) * 1024 * 256 : PIN(33) + (size_t)l * 1024 * 256;
        conv_tile(src, 256, 1024, 256, w1, 0, 32, r >> 2, r & 3, t);
    } else if (r < 128) {
        const float* src = (e < 64) ? PIN(31) + (size_t)(l * 64 + e) * 1024 * 256 : PIN(34) + (size_t)l * 1024 * 256;
        conv_tile(src, 256, 1024, 256, w1, 16, 32, (r - 64) >> 2, (r - 64) & 3, t);
    } else {
        const float* src = (e < 64) ? PIN(32) + (size_t)(l * 64 + e) * 256 * 1024 : PIN(35) + (size_t)l * 256 * 1024;
        conv_tile(src, 1024, 256, 1024, w2, 0, 16, (r - 128) >> 4, (r - 128) & 15, t);
    }
}
#define N_CONV_MOE 12480

DEVI void phase_mods(const Params& p, float* MOD, float* ROPE, float* ldsf) {
    const int tidx = TID();
    for (int it = blockIdx.x; it < 192; it += gridDim.x) {
        const int l = it / 96, n0 = (it % 96) * 64;
        for (int i = tidx; i < 5 * 1024; i += 512) { const int r = i >> 10, k = i & 1023; const float c = (r < 4) ? PIN(1)[r * 1024 + k] : PIN(3)[k]; ldsf[i] = c / (1.f + __expf(-c)); }
        __syncthreads();
        const int col = tidx & 63, ks = tidx >> 6;
        const float* wp = PIN(4) + (size_t)l * 1024 * 6144 + n0 + col;
        float acc[5] = {0.f, 0.f, 0.f, 0.f, 0.f};
#pragma unroll 8
        for (int k = ks * 128; k < ks * 128 + 128; ++k) {
            const float wv = wp[(size_t)k * 6144];
#pragma unroll
            for (int i = 0; i < 5; ++i) acc[i] += ldsf[i * 1024 + k] * wv;
        }
        float* red = ldsf + 5120;
#pragma unroll
        for (int i = 0; i < 5; ++i) red[(ks * 5 + i) * 64 + col] = acc[i];
        __syncthreads();
        if (tidx < 320) {
            const int i = tidx >> 6; float s = 0.f;
#pragma unroll
            for (int k2 = 0; k2 < 8; ++k2) s += red[(k2 * 5 + i) * 64 + col];
            MOD[(l * 5 + i) * 6144 + n0 + col] = s + PIN(5)[l * 6144 + n0 + col];
        }
        __syncthreads();
    }
    for (int idx = blockIdx.x * 512 + tidx; idx < 4096 * 16; idx += gridDim.x * 512) {
        const int t = idx >> 4, i = idx & 15;
        const float pos = (float)((i < 8) ? (t >> 6) : (t & 63));
        const float freq = powf(10000.f, -(float)(i & 7) / 8.f);
        float s, c; sincosf(pos * freq, &s, &c);
        ROPE[idx * 2] = c; ROPE[idx * 2 + 1] = s;
    }
}

DEVI void mlstm_local_item(const Params& p, int l, int item, const u16* Z, u16* MQ, u16* MK, float* GL, float* CLOC, float* lf) {
    const int tid = TID();
    const int tb = item % 68, h = (item / 68) & 3, b = item / 272;
    const int rowbase = (tb < 4) ? (RL + b * 256 + tb * 64) : (b * 4096 + (tb - 4) * 64);
    const int seglen = (tb < 4) ? TC : TL, tl0 = (tb < 4) ? tb * 64 : (tb - 4) * 64;
    float* kS = lf;
    float* vS = lf + 4096;
    float* gl = lf + 8192;
    float* eS = lf + 8448;
    float* sc = lf + 8576;
    {
        const int c = tid & 63, which = (tid >> 6) & 1, tg = tid >> 7;
        const int ch = which * 256 + h * 64 + c;
        const float w0 = PIN(7)[(l * 3 + 0) * 512 + ch], w1 = PIN(7)[(l * 3 + 1) * 512 + ch], w2 = PIN(7)[(l * 3 + 2) * 512 + ch];
        const int t0 = tg * 16;
        float zv[18];
#pragma unroll
        for (int i = 0; i < 18; ++i) {
            const int tl = tl0 + t0 - 1 + i;
            zv[i] = (tl >= 0 && tl < seglen) ? bf2f(Z[(size_t)(rowbase + t0 - 1 + i) * NIN + ch]) : 0.f;
        }
#pragma unroll
        for (int i = 0; i < 16; ++i) {
            const int t = t0 + i;
            const float y = w0 * zv[i] + w1 * zv[i + 1] + w2 * zv[i + 2];
            const float sv = y / (1.f + __expf(-y));
            if (which == 0) { MQ[(size_t)(rowbase + t) * 256 + h * 64 + c] = f2bf(sv * 0.125f); }
            else { MK[(size_t)(rowbase + t) * 256 + h * 64 + c] = f2bf(sv); kS[t * 64 + c] = sv; }
        }
        for (int i = tid; i < 4096; i += 512) { const int t = i >> 6, cc = i & 63; vS[i] = bf2f(Z[(size_t)(rowbase + t) * NIN + ZC_MV + h * 64 + cc]); }
        if (tid < 64) {
            const u16* zr = Z + (size_t)(rowbase + tid) * NIN + ZC_MG;
            const float* gb = PIN(8) + l * 16;
            const float lif = bf2f(zr[0 + h]) + gb[0 + h], lff = logsig(bf2f(zr[4 + h]) + gb[4 + h]);
            const float lib = bf2f(zr[8 + h]) + gb[8 + h], lfb = logsig(bf2f(zr[12 + h]) + gb[12 + h]);
            gl[tid] = lif; gl[64 + tid] = lff; gl[128 + tid] = lib; gl[192 + tid] = lfb;
            *(float4*)(GL + (size_t)(rowbase + tid) * 16 + h * 4) = make_float4(lif, lff, lib, lfb);
        }
    }
    __syncthreads();
    if (tid < 128) {
        const int dir = tid >> 6, s = tid & 63, tau = dir ? 63 - s : s;
        float bc = gl[(1 + 2 * dir) * 64 + tau];
#pragma unroll
        for (int o = 1; o < 64; o <<= 1) { const float u = __shfl_up(bc, o); if (s >= o) bc += u; }
        const float bend = __shfl(bc, 63);
        const float we = bend - bc + gl[(2 * dir) * 64 + tau];
        const float ml = wave_max(we);
        eS[dir * 64 + tau] = __expf(we - ml);
        if (s == 0) { sc[dir * 2] = ml; sc[dir * 2 + 1] = bend; }
    }
    __syncthreads();
#pragma unroll 1
    for (int dir = 0; dir < 2; ++dir) {
        const int c = dir ? ((tb < 4) ? 3 - tb : 71 - tb) : tb;
        const int seq = (dir * 4 + b) * 4 + h;
        float* rec = CLOC + (size_t)(seq * 68 + c) * CREC;
        const int v = tid >> 3, k0 = (tid & 7) * 8;
        float acc[8];
#pragma unroll
        for (int j = 0; j < 8; ++j) acc[j] = 0.f;
        for (int t = 0; t < 64; ++t) {
            const float ev = eS[dir * 64 + t] * vS[t * 64 + v];
            const float4 ka = *(const float4*)(kS + t * 64 + k0), kb = *(const float4*)(kS + t * 64 + k0 + 4);
            acc[0] += ev * ka.x; acc[1] += ev * ka.y; acc[2] += ev * ka.z; acc[3] += ev * ka.w;
            acc[4] += ev * kb.x; acc[5] += ev * kb.y; acc[6] += ev * kb.z; acc[7] += ev * kb.w;
        }
        *(float4*)(rec + v * 64 + k0) = make_float4(acc[0], acc[1], acc[2], acc[3]);
        *(float4*)(rec + v * 64 + k0 + 4) = make_float4(acc[4], acc[5], acc[6], acc[7]);
        if (tid < 64) {
            float n = 0.f;
            for (int t = 0; t < 64; ++t) n += eS[dir * 64 + t] * kS[t * 64 + tid];
            rec[4096 + tid] = n;
        }
        if (tid == 64) { rec[4160] = sc[dir * 2]; rec[4161] = sc[dir * 2 + 1]; }
    }
    __syncthreads();
}
DEVI void mlstm_scan_item(int item, float* CLOC, float* lf) {
    const int tid = TID(), seq = item / 9, sl = item % 9;
    float* base = CLOC + (size_t)seq * 68 * CREC;
    float* ao = lf; float* al = lf + 68; float* mp = lf + 136;
    if (tid < 68) { ao[tid] = base[(size_t)tid * CREC + 4160]; al[tid] = base[(size_t)tid * CREC + 4161]; }
    __syncthreads();
    if (tid == 0) {
        float m = 0.f;
        for (int c = 0; c < 68; ++c) {
            const float ml = ao[c], be = al[c];
            const float mn = fmaxf(be + m, ml);
            mp[c] = m; ao[c] = __expf(be + m - mn); al[c] = __expf(ml - mn); m = mn;
        }
    }
    __syncthreads();
    if (sl == 8 && tid < 68) base[(size_t)tid * CREC + 4162] = mp[tid];
    const bool act = (sl < 8) || (tid < 64);
    const int e = (sl < 8) ? sl * 512 + tid : 4096 + tid;
    float st = 0.f;
    if (act) {
#pragma unroll 1
        for (int c0 = 0; c0 < 68; c0 += 17) {
            float v[17];
#pragma unroll
            for (int j = 0; j < 17; ++j) v[j] = base[(size_t)(c0 + j) * CREC + e];
#pragma unroll
            for (int j = 0; j < 17; ++j) { base[(size_t)(c0 + j) * CREC + e] = st; st = ao[c0 + j] * st + al[c0 + j] * v[j]; }
        }
    }
    __syncthreads();
}
DEVI void mlstm_out_item(const Params& p, int l, int b, int h, int tb, const u16* Z, const u16* MQ, const u16* MK, const float* GL, const float* CLOC, u16* MIX, float* lf) {
    const int tid = TID();
    const int rowbase = (tb < 4) ? (RL + b * 256 + tb * 64) : (b * 4096 + (tb - 4) * 64);
    float* qS = lf;
    float* kS = qS + 4160;
    float* vS = kS + 4160;
    float* Cp = vS + 4096;
    float* Sm = Cp + 4160;
    float* hs = Sm + 4160;
    float* np = hs + 4160;
    float* bc = np + 64;
    float* lis = bc + 64;
    float* mrow = lis + 64;
    float* eint = mrow + 64;
    for (int i = tid; i < 4096; i += 512) {
        const int t = i >> 6, c = i & 63;
        qS[t * 65 + c] = bf2f(MQ[(size_t)(rowbase + t) * 256 + h * 64 + c]);
        kS[t * 65 + c] = bf2f(MK[(size_t)(rowbase + t) * 256 + h * 64 + c]);
        vS[t * 64 + c] = bf2f(Z[(size_t)(rowbase + t) * NIN + ZC_MV + h * 64 + c]);
        hs[t * 65 + c] = 0.f;
    }
    __syncthreads();
#pragma unroll 1
    for (int dir = 0; dir < 2; ++dir) {
        const int c = dir ? ((tb < 4) ? 3 - tb : 71 - tb) : tb;
        const int seq = (dir * 4 + b) * 4 + h;
        const float* rec = CLOC + (size_t)(seq * 68 + c) * CREC;
        const float mprev = rec[4162];
        for (int i = tid; i < 4096; i += 512) Cp[(i >> 6) * 65 + (i & 63)] = rec[i];
        if (tid < 64) np[tid] = rec[4096 + tid];
        if (tid < 64) {
            const int s = tid, tau = dir ? 63 - s : s;
            const float4 gv = *(const float4*)(GL + (size_t)(rowbase + tau) * 16 + h * 4);
            const float li = dir ? gv.z : gv.x, lfv = dir ? gv.w : gv.y;
            float cum = lfv;
#pragma unroll
            for (int o = 1; o < 64; o <<= 1) { const float u = __shfl_up(cum, o); if (s >= o) cum += u; }
            float pm = li - cum;
#pragma unroll
            for (int o = 1; o < 64; o <<= 1) { const float u = __shfl_up(pm, o); if (s >= o) pm = fmaxf(pm, u); }
            const float glog = cum + mprev, mr = fmaxf(glog, cum + pm);
            bc[s] = cum; lis[s] = li; mrow[s] = mr; eint[s] = __expf(glog - mr);
        }
        __syncthreads();
        {
            const int j = tid >> 3, s0 = (tid & 7) * 8;
            const int tj = dir ? 63 - j : j;
            float acc[8];
#pragma unroll
            for (int i = 0; i < 8; ++i) acc[i] = 0.f;
            if (s0 <= j) {
                for (int d = 0; d < 64; ++d) {
                    const float qv = qS[tj * 65 + d];
#pragma unroll
                    for (int i = 0; i < 8; ++i) { const int ts = dir ? 63 - (s0 + i) : (s0 + i); acc[i] += qv * kS[ts * 65 + d]; }
                }
            }
#pragma unroll
            for (int i = 0; i < 8; ++i) {
                const int s = s0 + i;
                Sm[j * 65 + s] = (s <= j) ? __expf(bc[j] - bc[s] + lis[s] - mrow[j]) * acc[i] : 0.f;
            }
        }
        __syncthreads();
        {
            const int j = tid >> 3, v0 = (tid & 7) * 8;
            const int tj = dir ? 63 - j : j;
            float acc[8];
#pragma unroll
            for (int i = 0; i < 8; ++i) acc[i] = 0.f;
            float den = 0.f;
            for (int s = 0; s <= j; ++s) {
                const float wv = Sm[j * 65 + s]; den += wv;
                const int ts = dir ? 63 - s : s;
                const float4 va = *(const float4*)(vS + ts * 64 + v0), vb = *(const float4*)(vS + ts * 64 + v0 + 4);
                acc[0] += wv * va.x; acc[1] += wv * va.y; acc[2] += wv * va.z; acc[3] += wv * va.w;
                acc[4] += wv * vb.x; acc[5] += wv * vb.y; acc[6] += wv * vb.z; acc[7] += wv * vb.w;
            }
            float ia[8];
#pragma unroll
            for (int i = 0; i < 8; ++i) ia[i] = 0.f;
            float nq = 0.f;
            for (int k = 0; k < 64; ++k) {
                const float qv = qS[tj * 65 + k]; nq += np[k] * qv;
#pragma unroll
                for (int i = 0; i < 8; ++i) ia[i] += Cp[(v0 + i) * 65 + k] * qv;
            }
            const float ei = eint[j];
            den += ei * nq;
            const float dn = 1.f / fmaxf(fabsf(den), __expf(-mrow[j]));
#pragma unroll
            for (int i = 0; i < 8; ++i) hs[tj * 65 + v0 + i] += (acc[i] + ei * ia[i]) * dn;
        }
        __syncthreads();
    }
    {
        const int t = tid >> 3, v0 = (tid & 7) * 8;
        float x[8]; float s = 0.f;
#pragma unroll
        for (int i = 0; i < 8; ++i) { x[i] = hs[t * 65 + v0 + i]; s += x[i]; }
        s += __shfl_xor(s, 1); s += __shfl_xor(s, 2); s += __shfl_xor(s, 4);
        const float mean = s * (1.f / 64.f);
        float q = 0.f;
#pragma unroll
        for (int i = 0; i < 8; ++i) { x[i] -= mean; q += x[i] * x[i]; }
        q += __shfl_xor(q, 1); q += __shfl_xor(q, 2); q += __shfl_xor(q, 4);
        const float rstd = rsqrtf(q * (1.f / 64.f) + 1e-6f);
        const u16* zo = Z + (size_t)(rowbase + t) * NIN + ZC_MO + h * 64 + v0;
        const float* nw = PIN(9) + l * 256 + h * 64 + v0;
        unsigned o[4];
#pragma unroll
        for (int i = 0; i < 4; ++i) {
            const float a0 = sigm(bf2f(zo[2 * i])) * x[2 * i] * rstd * nw[2 * i];
            const float a1 = sigm(bf2f(zo[2 * i + 1])) * x[2 * i + 1] * rstd * nw[2 * i + 1];
            o[i] = pack2(a0, a1);
        }
        *(uint4*)(MIX + (size_t)(rowbase + t) * 1024 + h * 64 + v0) = make_uint4(o[0], o[1], o[2], o[3]);
    }
    __syncthreads();
}

DEVI void prep_row(const Params& p, int l, int r, int lane, const u16* Z, u16* RR, u16* RK, u16* RV, u16* KK, u16* LI, u16* LA, u16* Kb, const float* ROPE) {
    const RowInfo ri = row_info(r);
    const u16* z0 = Z + (size_t)r * NIN;
    const bool hp = ri.t > 0, hn = ri.t < ri.seglen - 1;
    const float* mu = PIN(10) + l * 1152;
#pragma unroll
    for (int i = 0; i < 18; ++i) {
        const int c = lane + 64 * i;
        const float zc = bf2f(z0[ZC_RW + c]);
        const float zp = hp ? bf2f(z0[ZC_RW + c - NIN]) : 0.f, zn = hn ? bf2f(z0[ZC_RW + c + NIN]) : 0.f;
        const float zs = zc + mu[c] * (0.5f * (zp + zn) - zc);
        if (i < 4) RR[(size_t)r * 256 + c] = f2bf(zs);
        else if (i < 8) {
            RK[(size_t)r * 256 + c - 256] = f2bf(zs);
            const float kr = zs * PIN(16)[l * 256 + c - 256];
            const float ss = wave_sum(kr * kr);
            KK[(size_t)r * 256 + c - 256] = f2bf(kr * rsqrtf(fmaxf(ss, 1e-12f)));
        }
        else if (i < 12) RV[(size_t)r * 256 + c - 512] = f2bf(zs);
        else if (i < 14) LI[(size_t)r * 384 + c - 768] = f2bf(tanh_(zs));
        else if (i < 16) LI[(size_t)r * 384 + 128 + c - 896] = f2bf(zs);
        else LI[(size_t)r * 384 + 256 + c - 1024] = f2bf(sigm(zs));
    }
    {
        float zq[4]; float s = 0.f;
#pragma unroll
        for (int i = 0; i < 4; ++i) { zq[i] = bf2f(z0[ZC_MLA + lane + 64 * i]); s += zq[i] * zq[i]; }
        float rs = rsqrtf(wave_sum(s) * (1.f / 256.f) + 1e-6f);
#pragma unroll
        for (int i = 0; i < 4; ++i) LA[(size_t)r * 384 + lane + 64 * i] = f2bf(zq[i] * rs * PIN(21)[l * 256 + lane + 64 * i]);
        float zk[2]; s = 0.f;
#pragma unroll
        for (int i = 0; i < 2; ++i) { zk[i] = bf2f(z0[ZC_MLA + 256 + lane + 64 * i]); s += zk[i] * zk[i]; }
        rs = rsqrtf(wave_sum(s) * (1.f / 128.f) + 1e-6f);
#pragma unroll
        for (int i = 0; i < 2; ++i) LA[(size_t)r * 384 + 256 + lane + 64 * i] = f2bf(zk[i] * rs * PIN(22)[l * 128 + lane + 64 * i]);
        const float x = (lane < 32) ? bf2f(z0[ZC_MLA + 384 + lane]) : 0.f;
        const float xo = __shfl_xor(x, 1);
        float o = x;
        if (!ri.isctx) {
            const int pi = (lane & 31) >> 1;
            const float cs = ROPE[(ri.t * 16 + pi) * 2], sn = ROPE[(ri.t * 16 + pi) * 2 + 1];
            o = (lane & 1) ? (xo * sn + x * cs) : (x * cs - xo * sn);
        }
        if (lane < 32) {
            const int idx = ri.isctx ? 4096 + ri.t : ri.t;
            const u16 ob = f2bf(o);
#pragma unroll
            for (int hh = 0; hh < 8; ++hh) Kb[((size_t)(ri.b * 8 + hh) * NKEY + idx) * 96 + 64 + lane] = ob;
        }
    }
}

#define RW_TB 32
typedef float f32x2 __attribute__((ext_vector_type(2)));
DEVI void rwkv_scan_block(int bk, const float* WDp, const u16* KKp, const u16* KKAp, const u16* KVECp, const u16* RRp, const u16* RVp, float* OFBp, float* lf) {
    const int tid = TID(), lane = tid & 63, w = tid >> 6;
    const int seq = bk >> 2, quarter = bk & 3;
    const int dir = seq >> 4, b = (seq >> 2) & 3, h = seq & 3;
    const int kq = lane & 15, rr = lane >> 4;
    const int vrow = 16 * quarter + 4 * (w & 3) + rr;
    const float* wd = WDp + (size_t)dir * RT * 256 + h * 64;
    const u16* kk = KKp + h * 64; const u16* kka = KKAp + (size_t)dir * RT * 256 + h * 64; const u16* kvec = KVECp + (size_t)dir * RT * 256 + h * 64;
    const u16* rrp = RRp + h * 64; const u16* rvp = RVp + h * 64;
    float* outp = OFBp + (size_t)dir * RT * 256 + h * 64 + vrow;
    auto srow = [&](int s) -> int { return (s < 256) ? (RL + b * 256 + (dir ? 255 - s : s)) : (b * 4096 + (dir ? 4095 - (s - 256) : (s - 256))); };
    const int nb = NKEY / RW_TB;
    if (w >= 4) {
        const int lt = tid - 256, lstep = lt >> 3, lpart = lt & 7;
        float4 pw0, pw1; uint4 pk, pka, pkv, pr, pv;
        auto gload = [&](int s0) {
            const size_t ro = (size_t)srow(s0 + lstep) * 256 + lpart * 8;
            pw0 = *(const float4*)(wd + ro); pw1 = *(const float4*)(wd + ro + 4);
            pk = *(const uint4*)(kk + ro); pka = *(const uint4*)(kka + ro); pkv = *(const uint4*)(kvec + ro); pr = *(const uint4*)(rrp + ro); pv = *(const uint4*)(rvp + ro);
        };
        auto st8 = [&](float* d, uint4 v) {
            *(float4*)(d) = make_float4(__uint_as_float(v.x << 16), __uint_as_float(v.x & 0xffff0000u), __uint_as_float(v.y << 16), __uint_as_float(v.y & 0xffff0000u));
            *(float4*)(d + 4) = make_float4(__uint_as_float(v.z << 16), __uint_as_float(v.z & 0xffff0000u), __uint_as_float(v.w << 16), __uint_as_float(v.w & 0xffff0000u));
        };
        auto lstore = [&](int bsel) {
            float* d = lf + bsel * (RW_TB * 384) + lstep * 384 + lpart * 8;
            *(float4*)(d) = pw0; *(float4*)(d + 4) = pw1; st8(d + 64, pk); st8(d + 128, pka); st8(d + 192, pkv); st8(d + 256, pr); st8(d + 320, pv);
        };
        gload(0); lstore(0);
        __syncthreads();
#pragma unroll 1
        for (int bt = 0; bt < nb; ++bt) {
            if (bt + 1 < nb) { gload((bt + 1) * RW_TB); lstore((bt + 1) & 1); }
            __syncthreads();
        }
    } else {
        __builtin_amdgcn_s_setprio(2);
        f32x2 Sa = {0.f, 0.f}, Sb = {0.f, 0.f};
        __syncthreads();
#pragma unroll 1
        for (int bt = 0; bt < nb; ++bt) {
            const float* base = lf + (bt & 1) * (RW_TB * 384);
#pragma unroll 1
            for (int s16 = 0; s16 < RW_TB; s16 += 16) {
                float keep = 0.f;
#pragma unroll
                for (int sj = 0; sj < 16; ++sj) {
                    const int s = s16 + sj;
                    const float* o = base + s * 384 + kq * 4;
                    const float4 w4 = *(const float4*)(o), k4 = *(const float4*)(o + 64), a4 = *(const float4*)(o + 128), c4 = *(const float4*)(o + 192), r4 = *(const float4*)(o + 256);
                    const float vv = base[s * 384 + 320 + vrow];
                    const f32x2 wa = {w4.x, w4.y}, wb = {w4.z, w4.w}, ka = {k4.x, k4.y}, kb = {k4.z, k4.w}, aa = {a4.x, a4.y}, ab = {a4.z, a4.w};
                    const f32x2 ca = {c4.x, c4.y}, cb = {c4.z, c4.w}, ra = {r4.x, r4.y}, rb = {r4.z, r4.w};
                    f32x2 dd = Sa * ka + Sb * kb;
                    const float d = -red16(dd.x + dd.y);
                    const f32x2 ta = d * aa + vv * ca, tb = d * ab + vv * cb;
                    Sa = Sa * wa + ta; Sb = Sb * wb + tb;
                    f32x2 oo = Sa * ra + Sb * rb;
                    const float ov = red16(oo.x + oo.y);
                    keep = (kq == sj) ? ov : keep;
                }
                outp[(size_t)srow(bt * RW_TB + s16 + kq) * 256] = keep;
            }
            __syncthreads();
        }
        __builtin_amdgcn_s_setprio(0);
    }
}

struct AttnRegs { uint4 k0, k1, v; };
DEVI void attn_item(int b, int h, int q0, int key0, int nkt, int outrow0, const u16* Qp, const u16* Kp, const u16* VTp, u16* MIXp, u16* ls) {
    const int tid = TID(), lane = tid & 63, w = tid >> 6, g = lane >> 4, li = lane & 15;
    const u16* Qh = Qp + (size_t)(b * 8 + h) * NKEY * 96;
    const u16* Kh = Kp + (size_t)(b * 8 + h) * NKEY * 96;
    const u16* Vh = VTp + (size_t)(b * 8 + h) * 64 * NKEY;
    u16* Ks = ls; u16* Vs = ls + 2 * 64 * 104;
    bf16x8 qf[2][3];
#pragma unroll
    for (int qs = 0; qs < 2; ++qs)
#pragma unroll
        for (int ks = 0; ks < 3; ++ks) qf[qs][ks] = *(const bf16x8*)(Qh + (size_t)(q0 + 32 * w + 16 * qs + li) * 96 + ks * 32 + g * 8);
    const int kr0 = tid / 12, kc0 = tid % 12, kr1 = (tid + 512) / 12, kc1 = (tid + 512) % 12;
    const int vr = tid >> 3, vc = tid & 7;
    auto gload = [&](AttnRegs& R, int kt) {
        const int kb = key0 + kt * 64;
        R.k0 = *(const uint4*)(Kh + (size_t)(kb + kr0) * 96 + kc0 * 8);
        if (tid < 256) R.k1 = *(const uint4*)(Kh + (size_t)(kb + kr1) * 96 + kc1 * 8);
        R.v = *(const uint4*)(Vh + (size_t)vr * NKEY + kb + vc * 8);
    };
    auto lstore = [&](const AttnRegs& R, int bsel) {
        *(uint4*)(Ks + bsel * 64 * 104 + kr0 * 104 + kc0 * 8) = R.k0;
        if (tid < 256) *(uint4*)(Ks + bsel * 64 * 104 + kr1 * 104 + kc1 * 8) = R.k1;
        *(uint4*)(Vs + bsel * 64 * 72 + vr * 72 + vc * 8) = R.v;
    };
    f32x4 oacc[2][4];
#pragma unroll
    for (int qs = 0; qs < 2; ++qs)
#pragma unroll
        for (int mt = 0; mt < 4; ++mt) oacc[qs][mt] = (f32x4){0.f, 0.f, 0.f, 0.f};
    float m[2] = {-1e30f, -1e30f}, lsum[2] = {0.f, 0.f};
    auto compute = [&](int bsel) {
        const u16* K0 = Ks + bsel * 64 * 104; const u16* V0 = Vs + bsel * 64 * 72;
        f32x4 st[2][4];
#pragma unroll
        for (int k4 = 0; k4 < 4; ++k4) {
            st[0][k4] = (f32x4){0.f, 0.f, 0.f, 0.f}; st[1][k4] = (f32x4){0.f, 0.f, 0.f, 0.f};
#pragma unroll
            for (int ks = 0; ks < 3; ++ks) {
                const bf16x8 a = *(const bf16x8*)(K0 + (k4 * 16 + li) * 104 + ks * 32 + g * 8);
                st[0][k4] = __builtin_amdgcn_mfma_f32_16x16x32_bf16(a, qf[0][ks], st[0][k4], 0, 0, 0);
                st[1][k4] = __builtin_amdgcn_mfma_f32_16x16x32_bf16(a, qf[1][ks], st[1][k4], 0, 0, 0);
            }
        }
        union PF { bf16x8 v; unsigned u[4]; } pf[2][2];
#pragma unroll
        for (int qs = 0; qs < 2; ++qs) {
            float mx = -1e30f;
#pragma unroll
            for (int k4 = 0; k4 < 4; ++k4)
#pragma unroll
                for (int j = 0; j < 4; ++j) mx = fmaxf(mx, st[qs][k4][j]);
            mx = xrow16_max(mx);
            const float mn = fmaxf(m[qs], mx);
            if (__any(mn > m[qs])) {
                const float alpha = __builtin_amdgcn_exp2f(m[qs] - mn);
                m[qs] = mn;
                lsum[qs] *= alpha;
#pragma unroll
                for (int mt = 0; mt < 4; ++mt) { oacc[qs][mt][0] *= alpha; oacc[qs][mt][1] *= alpha; oacc[qs][mt][2] *= alpha; oacc[qs][mt][3] *= alpha; }
            }
            float ps = 0.f;
#pragma unroll
            for (int k4 = 0; k4 < 4; ++k4)
#pragma unroll
                for (int j = 0; j < 4; ++j) { const float pv = __builtin_amdgcn_exp2f(st[qs][k4][j] - mn); st[qs][k4][j] = pv; ps += pv; }
            lsum[qs] += ps;
#pragma unroll
            for (int pp = 0; pp < 2; ++pp) {
                pf[qs][pp].u[0] = pack2(st[qs][2 * pp][0], st[qs][2 * pp][1]); pf[qs][pp].u[1] = pack2(st[qs][2 * pp][2], st[qs][2 * pp][3]);
                pf[qs][pp].u[2] = pack2(st[qs][2 * pp + 1][0], st[qs][2 * pp + 1][1]); pf[qs][pp].u[3] = pack2(st[qs][2 * pp + 1][2], st[qs][2 * pp + 1][3]);
            }
        }
#pragma unroll
        for (int pp = 0; pp < 2; ++pp)
#pragma unroll
            for (int mt = 0; mt < 4; ++mt) {
                union { bf16x8 v; uint2 u[2]; } vf;
                vf.u[0] = *(const uint2*)(V0 + (mt * 16 + li) * 72 + 32 * pp + 4 * g);
                vf.u[1] = *(const uint2*)(V0 + (mt * 16 + li) * 72 + 32 * pp + 16 + 4 * g);
                oacc[0][mt] = __builtin_amdgcn_mfma_f32_16x16x32_bf16(vf.v, pf[0][pp].v, oacc[0][mt], 0, 0, 0);
                oacc[1][mt] = __builtin_amdgcn_mfma_f32_16x16x32_bf16(vf.v, pf[1][pp].v, oacc[1][mt], 0, 0, 0);
            }
    };
    AttnRegs rA, rB;
    rA.k1 = make_uint4(0, 0, 0, 0); rB.k1 = make_uint4(0, 0, 0, 0);
    gload(rA, 0); lstore(rA, 0); gload(rB, 1);
    __syncthreads();
#pragma unroll 1
    for (int kt = 0; kt < nkt; kt += 2) {
        if (kt + 2 < nkt) gload(rA, kt + 2);
        compute(0);
        lstore(rB, 1);
        __syncthreads();
        if (kt + 3 < nkt) gload(rB, kt + 3);
        compute(1);
        if (kt + 2 < nkt) lstore(rA, 0);
        __syncthreads();
    }
#pragma unroll
    for (int qs = 0; qs < 2; ++qs) {
        float ls2 = lsum[qs];
        ls2 = xrow16_sum(ls2);
        const float inv = 1.f / ls2;
        u16* orow = MIXp + (size_t)(outrow0 + 32 * w + 16 * qs + li) * 1024 + 512 + h * 64;
#pragma unroll
        for (int mt = 0; mt < 4; ++mt) {
            uint2 o; o.x = pack2(oacc[qs][mt][0] * inv, oacc[qs][mt][1] * inv); o.y = pack2(oacc[qs][mt][2] * inv, oacc[qs][mt][3] * inv);
            *(uint2*)(orow + mt * 16 + 4 * g) = o;
        }
    }
}

#define G_HT 8192
DEVI int g_lds_byte(int r, int c) {
    const int st = (r >> 4) * 2 + (c >> 5), rr = r & 15, cc = c & 31, ob = rr * 64 + cc * 2;
    return st * 1024 + (ob ^ (((ob >> 9) & 1) << 5));
}
DEVI void g_stage_rc(int b, int& R, int& C) {
    const int st = b / 1024, sb = b % 1024, swz = sb ^ (((sb >> 9) & 1) << 5);
    R = (st >> 1) * 16 + swz / 64; C = (st & 1) * 32 + (swz % 64) / 2;
}
template <bool AG>
DEVI void gemm256_tile(u16* shm, const u16* Ab, const unsigned (&aoff)[2], const unsigned (&aoff1)[2], unsigned ahs, const u16* Bb, const unsigned (&boff)[2], unsigned bhs, int K,
                       f32x4 (&acc)[2][2][4][2], int tid, int wr, int wc, int fr, int fq) {
    const int wbase = (wr * 4 + wc) * 1024;
    (void)tid;
#define G_SA(b, h) (shm + ((b) * 2 + (h)) * G_HT)
#define G_SB(b, h) (shm + (4 + (b) * 2 + (h)) * G_HT)
#define G_STAGE_A(P, h, kt) do { const char* _b = (const char*)(Ab + (size_t)(kt) * 64 + ((!AG && (h)) ? ahs : 0u)); \
    __builtin_amdgcn_global_load_lds((const unsigned*)(_b + ((AG && (h)) ? aoff1[0] : aoff[0])), (unsigned*)((char*)(P) + wbase), 16, 0, 0); \
    __builtin_amdgcn_global_load_lds((const unsigned*)(_b + ((AG && (h)) ? aoff1[1] : aoff[1])), (unsigned*)((char*)(P) + wbase + 8192), 16, 0, 0); } while (0)
#define G_STAGE_B(P, h, kt) do { const char* _b = (const char*)(Bb + (size_t)(kt) * 64 + ((h) ? bhs : 0u)); \
    __builtin_amdgcn_global_load_lds((const unsigned*)(_b + boff[0]), (unsigned*)((char*)(P) + wbase), 16, 0, 0); \
    __builtin_amdgcn_global_load_lds((const unsigned*)(_b + boff[1]), (unsigned*)((char*)(P) + wbase + 8192), 16, 0, 0); } while (0)
#define G_LDA(dst, b, h) _Pragma("unroll") for (int m = 0; m < 4; ++m) _Pragma("unroll") for (int k = 0; k < 2; ++k) \
    dst[m][k] = *reinterpret_cast<const bf16x8*>((const char*)G_SA(b, h) + g_lds_byte(wr * 64 + m * 16 + fr, k * 32 + fq * 8))
#define G_LDB(dst, b, h) _Pragma("unroll") for (int n = 0; n < 2; ++n) _Pragma("unroll") for (int k = 0; k < 2; ++k) \
    dst[n][k] = *reinterpret_cast<const bf16x8*>((const char*)G_SB(b, h) + g_lds_byte(wc * 32 + n * 16 + fr, k * 32 + fq * 8))
#define G_MMA(ai, bj, At_, Bt_) do { __builtin_amdgcn_s_setprio(1); \
    _Pragma("unroll") for (int m = 0; m < 4; ++m) _Pragma("unroll") for (int n = 0; n < 2; ++n) _Pragma("unroll") for (int k = 0; k < 2; ++k) \
      acc[ai][bj][m][n] = __builtin_amdgcn_mfma_f32_16x16x32_bf16(Bt_[n][k], At_[m][k], acc[ai][bj][m][n], 0, 0, 0); \
    __builtin_amdgcn_s_setprio(0); } while (0)
#define G_WAIT_V(n) asm volatile("s_waitcnt vmcnt(" #n ")" ::: "memory")
#define G_WAIT_L(n) asm volatile("s_waitcnt lgkmcnt(" #n ")" ::: "memory")
#define G_BAR __builtin_amdgcn_s_barrier()
#define G_SCHED __builtin_amdgcn_sched_barrier(0)
#pragma unroll
    for (int ai = 0; ai < 2; ++ai)
#pragma unroll
        for (int bj = 0; bj < 2; ++bj)
#pragma unroll
            for (int m = 0; m < 4; ++m)
#pragma unroll
                for (int n = 0; n < 2; ++n) acc[ai][bj][m][n] = (f32x4){0.f, 0.f, 0.f, 0.f};
    bf16x8 At[4][2], B0[2][2], B1[2][2];
    const int nt = K / 64;
    G_STAGE_B(G_SB(0, 0), 0, 0); G_STAGE_A(G_SA(0, 0), 0, 0);
    G_STAGE_B(G_SB(0, 1), 1, 0); G_STAGE_A(G_SA(0, 1), 1, 0);
    if (wr == 1) G_BAR;
    G_WAIT_V(4); G_BAR;
    G_STAGE_B(G_SB(1, 0), 0, 1); G_STAGE_A(G_SA(1, 0), 0, 1); G_STAGE_B(G_SB(1, 1), 1, 1);
    G_WAIT_V(6); G_BAR;
#pragma unroll 1
    for (int t = 0; t < nt - 2; t += 2) {
        G_LDB(B0, 0, 0); G_SCHED; G_LDA(At, 0, 0); G_STAGE_A(G_SA(1, 1), 1, t + 1);
        G_WAIT_L(8); G_BAR; G_WAIT_L(0); G_MMA(0, 0, At, B0); G_BAR; G_SCHED;
        G_LDB(B1, 0, 1); G_STAGE_B(G_SB(0, 0), 0, t + 2);
        G_BAR; G_WAIT_L(0); G_MMA(0, 1, At, B1); G_BAR;
        G_LDA(At, 0, 1); G_STAGE_A(G_SA(0, 0), 0, t + 2);
        G_BAR; G_WAIT_L(0); G_MMA(1, 0, At, B0); G_BAR; G_SCHED;
        G_STAGE_B(G_SB(0, 1), 1, t + 2);
        G_WAIT_V(6); G_BAR; G_MMA(1, 1, At, B1); G_BAR;
        G_LDB(B0, 1, 0); G_SCHED; G_LDA(At, 1, 0); G_STAGE_A(G_SA(0, 1), 1, t + 2);
        G_WAIT_L(8); G_BAR; G_WAIT_L(0); G_MMA(0, 0, At, B0); G_BAR; G_SCHED;
        G_LDB(B1, 1, 1); G_STAGE_B(G_SB(1, 0), 0, t + 3);
        G_BAR; G_WAIT_L(0); G_MMA(0, 1, At, B1); G_BAR;
        G_LDA(At, 1, 1); G_STAGE_A(G_SA(1, 0), 0, t + 3);
        G_BAR; G_WAIT_L(0); G_MMA(1, 0, At, B0); G_BAR; G_SCHED;
        G_STAGE_B(G_SB(1, 1), 1, t + 3);
        G_WAIT_V(6); G_BAR; G_MMA(1, 1, At, B1); G_BAR;
    }
    {   G_LDB(B0, 0, 0); G_LDA(At, 0, 0); G_STAGE_A(G_SA(1, 1), 1, nt - 1);
        G_BAR; G_WAIT_L(0); G_MMA(0, 0, At, B0); G_BAR;
        G_LDB(B1, 0, 1); G_BAR; G_WAIT_L(0); G_MMA(0, 1, At, B1); G_BAR;
        G_LDA(At, 0, 1); G_WAIT_V(4); G_BAR; G_WAIT_L(0); G_MMA(1, 0, At, B0); G_MMA(1, 1, At, B1); G_BAR; }
    {   G_LDB(B0, 1, 0); G_LDA(At, 1, 0); G_WAIT_V(2); G_BAR; G_WAIT_L(0); G_MMA(0, 0, At, B0); G_BAR;
        G_LDB(B1, 1, 1); G_WAIT_V(0); G_BAR; G_WAIT_L(0); G_MMA(0, 1, At, B1); G_BAR;
        G_LDA(At, 1, 1); G_BAR; G_WAIT_L(0); G_MMA(1, 0, At, B0); G_MMA(1, 1, At, B1); G_BAR; }
    if (wr == 0) G_BAR;
}
#define G_PIECE(i, R, C) int R, C; g_stage_rc(tid * 16 + (i) * 8192, R, C)
#define G_ROW(ai, m) ((ai) * 128 + wr * 64 + (m) * 16 + fr)
#define G_COL(bj, n) ((bj) * 128 + wc * 32 + (n) * 16 + fq * 4)
#define G_IDS const int tid = TID(), wid = __builtin_amdgcn_readfirstlane(tid >> 6), lane = tid & 63, wr = wid >> 2, wc = wid & 3, fr = lane & 15, fq = lane >> 4; (void)lane;

#define CTL  ((unsigned*)(ws + OFF_CTL))
#define MOD  ((float*)(ws + OFF_MOD))
#define ROPE ((float*)(ws + OFF_ROPE))
#define XC   ((float*)(ws + OFF_XC))
#define WTM  ((u16*)(ws + OFF_WTM))
#define H    ((u16*)(ws + OFF_H))
#define MIX  ((u16*)(ws + OFF_H))
#define Z    ((u16*)(ws + S_Z))
#define MQ   ((u16*)(ws + S_MQ))
#define MK   ((u16*)(ws + S_MK))
#define GL   ((float*)(ws + S_GL))
#define CLOC ((float*)(ws + S_CLOC))
#define WD   ((float*)(ws + S_WD))
#define KK   ((u16*)(ws + S_KK))
#define KKA  ((u16*)(ws + S_KKA))
#define KVEC ((u16*)(ws + S_KVEC))
#define RR   ((u16*)(ws + S_RR))
#define RV   ((u16*)(ws + S_RV))
#define RK   ((u16*)(ws + S_RK))
#define GG   ((u16*)(ws + S_G))
#define LI   ((u16*)(ws + S_LI))
#define LA   ((u16*)(ws + S_LA))
#define OFB  ((float*)(ws + S_OF))
#define Qb   ((u16*)(ws + S_Q))
#define Kb   ((u16*)(ws + S_K))
#define VTb  ((u16*)(ws + S_VT))
#define Y    ((float*)(ws + S_Y))
#define YEXP ((u16*)(ws + S_YEXP))
#define WTE  ((u16*)(ws + S_WTE))
#define TOK  ((int*)(ws + S_TOK))
#define GATE ((float*)(ws + S_GATE))
#define SLOT ((int*)(ws + S_SLOT))
#define ACT  ((u16*)(ws + S_ACT))

__global__ void __launch_bounds__(512) mega(Params p) {
    __shared__ __attribute__((aligned(16))) unsigned char lds[LDS_BYTES];
    int tid = threadIdx.x, lane = tid & 63, wv = tid >> 6;
    const int G = gridDim.x, bid = blockIdx.x;
#define REFRESH() do { asm volatile("" : "+v"(tid)); asm volatile("" : "+s"(ws)); lane = tid & 63; wv = tid >> 6; } while (0)
#define STAMP(k) do { if (PROF && bid == 0 && tid == 0) ((unsigned long long*)(CTL + CW_TS))[(k)] = __builtin_amdgcn_s_memrealtime(); } while (0)
    unsigned char* ws = (unsigned char*)PIN(39);
    float* lf = (float*)lds; u16* ls = (u16*)lds;
    volatile LAS unsigned* bst = (volatile LAS unsigned*)(lds + LDS_BYTES - 16);
    int* misc = (int*)(lds + LDS_BYTES - 64);
    if (tid < 4) bst[tid] = 0u;
    __syncthreads();
    XcdBarrier bar = xcd_barrier_post(CTL, bst);
    STAMP(0);
#define x_in (PIN(0))
#define ctx_in (PIN(2))
#define OUT ((float*)PIN(38))

    phase_mods(p, MOD, ROPE, lf);
    for (int it = bid; it < N_CONV_MIXER; it += G) conv_mixer_item(p, 0, it, WTM, ls);
    xcd_barrier(bar); STAMP(1);
    for (int r = bid * 8 + wv; r < RT; r += G * 8) {
        const RowInfo ri = row_info(r);
        const float* xr = ri.isctx ? ctx_in + (size_t)(r - RL) * 1024 : x_in + (size_t)r * 1024;
        float4 a[4]; row_load(xr, lane, a); row_ln(a);
        const float* md = MOD + (0 * 5 + ri.mi) * 6144;
        row_affine(a, md + 1024, md, lane, 1.f);
        row_store_bf16(H + (size_t)r * 1024, lane, a);
    }
    xcd_barrier(bar); STAMP(2);

#pragma unroll 1
    for (int l = 0; l < 2; ++l) {
        const bool last = (l == 1);
        const int Rl = last ? RL : RT;
        REFRESH();
        for (int it = bid; it < 68 * 11; it += G) {
            const int m0 = (it / 11) * 256, n0 = (it % 11) * 256;
            G_IDS
            unsigned aoff[2], boff[2];
#pragma unroll
            for (int i = 0; i < 2; ++i) { G_PIECE(i, R, C); aoff[i] = ((unsigned)(m0 + R) * 1024u + C) * 2u; boff[i] = ((unsigned)(n0 + R) * 1024u + C) * 2u; }
            f32x4 acc[2][2][4][2];
            gemm256_tile<false>(ls, H, aoff, aoff, 128u * 1024u, WTM + WTM_WIN, boff, 128u * 1024u, 1024, acc, tid, wr, wc, fr, fq);
#pragma unroll
            for (int ai = 0; ai < 2; ++ai)
#pragma unroll
                for (int bj = 0; bj < 2; ++bj)
#pragma unroll
                    for (int m = 0; m < 4; ++m)
#pragma unroll
                        for (int n = 0; n < 2; ++n) {
                            const int row = m0 + G_ROW(ai, m), col = n0 + G_COL(bj, n);
                            if (col < NIN) { uint2 o; o.x = pack2(acc[ai][bj][m][n][0], acc[ai][bj][m][n][1]); o.y = pack2(acc[ai][bj][m][n][2], acc[ai][bj][m][n][3]); *(uint2*)(Z + (size_t)row * NIN + col) = o; }
                        }
            asm volatile("s_waitcnt vmcnt(0)" ::: "memory");
        }
        xcd_barrier(bar); STAMP(3 + l * 9 + 0);
        REFRESH();
        for (int it = bid; it < 1088 + 2176; it += G) {
            if (it < 1088) mlstm_local_item(p, l, it, Z, MQ, MK, GL, CLOC, lf);
            else prep_row(p, l, (it - 1088) * 8 + wv, lane, Z, RR, RK, RV, KK, LI, LA, Kb, ROPE);
        }
        xcd_barrier(bar); STAMP(3 + l * 9 + 1);
        REFRESH();
        for (int it = bid; it < 288 + 3264; it += G) {
            if (it < 288) { mlstm_scan_item(it, CLOC, lf); continue; }
            int gi = it - 288;
            EPI_IDS
            f32x4 acc[2][4];
            if (gi < 1088) {
                const int kind = gi / 272, t2 = gi % 272, m0 = (t2 >> 1) * 128, n0 = (t2 & 1) * 128, d = kind & 1;
                const u16* A = LI + (size_t)(m0 + (tid >> 2)) * 384 + (kind >> 1) * 128 + d * 64 + (tid & 3) * 8;
                const u16* B = WTM + ((kind >> 1) ? WTM_AUP : WTM_WUP) + (size_t)d * 256 * 64 + (size_t)(n0 + (tid >> 2)) * 64 + (tid & 3) * 8;
                gemm_core<false>(ls, A, B, nullptr, 0, 64, acc);
#pragma unroll
                for (int nt = 0; nt < 2; ++nt)
#pragma unroll
                    for (int mt = 0; mt < 4; ++mt) {
                        const int n = n0 + EPI_N(nt), m = m0 + EPI_M(mt);
                        if (kind < 2) {
                            const float4 w0 = *(const float4*)(PIN(11) + (l * 2 + d) * 256 + n);
                            float4 o;
                            o.x = __expf(-0.60653065971263342f * sigm(w0.x + acc[nt][mt][0])); o.y = __expf(-0.60653065971263342f * sigm(w0.y + acc[nt][mt][1]));
                            o.z = __expf(-0.60653065971263342f * sigm(w0.z + acc[nt][mt][2])); o.w = __expf(-0.60653065971263342f * sigm(w0.w + acc[nt][mt][3]));
                            *(float4*)(WD + ((size_t)d * RT + m) * 256 + n) = o;
                        } else {
                            const float4 a0 = *(const float4*)(PIN(13) + (l * 2 + d) * 256 + n);
                            const float4 ka = *(const float4*)(PIN(17) + l * 256 + n);
                            const uint2 kkv = *(const uint2*)(KK + (size_t)m * 256 + n), kv = *(const uint2*)(RK + (size_t)m * 256 + n);
                            const float a_0 = sigm(a0.x + acc[nt][mt][0]), a_1 = sigm(a0.y + acc[nt][mt][1]), a_2 = sigm(a0.z + acc[nt][mt][2]), a_3 = sigm(a0.w + acc[nt][mt][3]);
                            const float kk0 = __uint_as_float(kkv.x << 16), kk1 = __uint_as_float(kkv.x & 0xffff0000u), kk2 = __uint_as_float(kkv.y << 16), kk3 = __uint_as_float(kkv.y & 0xffff0000u);
                            const float k0 = __uint_as_float(kv.x << 16), k1 = __uint_as_float(kv.x & 0xffff0000u), k2 = __uint_as_float(kv.y << 16), k3 = __uint_as_float(kv.y & 0xffff0000u);
                            uint2 o1, o2;
                            o1.x = pack2(kk0 * a_0, kk1 * a_1); o1.y = pack2(kk2 * a_2, kk3 * a_3);
                            o2.x = pack2(k0 * (1.f + (a_0 - 1.f) * ka.x), k1 * (1.f + (a_1 - 1.f) * ka.y)); o2.y = pack2(k2 * (1.f + (a_2 - 1.f) * ka.z), k3 * (1.f + (a_3 - 1.f) * ka.w));
                            *(uint2*)(KKA + ((size_t)d * RT + m) * 256 + n) = o1;
                            *(uint2*)(KVEC + ((size_t)d * RT + m) * 256 + n) = o2;
                        }
                    }
                continue;
            }
            gi -= 1088;
            if (gi < 272) {
                const int m0 = (gi >> 1) * 128, n0 = (gi & 1) * 128;
                gemm_core<false>(ls, LI + (size_t)(m0 + (tid >> 2)) * 384 + 256 + (tid & 3) * 8, WTM + WTM_GUP + (size_t)(n0 + (tid >> 2)) * 128 + (tid & 3) * 8, nullptr, 0, 128, acc);
#pragma unroll
                for (int nt = 0; nt < 2; ++nt)
#pragma unroll
                    for (int mt = 0; mt < 4; ++mt) {
                        const int n = n0 + EPI_N(nt), m = m0 + EPI_M(mt);
                        uint2 o; o.x = pack2(acc[nt][mt][0], acc[nt][mt][1]); o.y = pack2(acc[nt][mt][2], acc[nt][mt][3]);
                        *(uint2*)(GG + (size_t)m * 256 + n) = o;
                    }
                continue;
            }
            gi -= 272;
            if (gi < 816) {
                const int m0 = (gi / 6) * 128, n0 = (gi % 6) * 128;
                gemm_core<false>(ls, LA + (size_t)(m0 + (tid >> 2)) * 384 + (tid & 3) * 8, WTM + WTM_UQ + (size_t)(n0 + (tid >> 2)) * 256 + (tid & 3) * 8, nullptr, 0, 256, acc);
#pragma unroll
                for (int nt = 0; nt < 2; ++nt)
#pragma unroll
                    for (int mt = 0; mt < 4; ++mt) {
                        const int n = n0 + EPI_N(nt), m = m0 + EPI_M(mt);
                        const RowInfo ri = row_info(m);
                        const int hh = n / 96, j = n % 96, idx = ri.isctx ? 4096 + ri.t : ri.t;
                        float x0 = acc[nt][mt][0], x1 = acc[nt][mt][1], x2 = acc[nt][mt][2], x3 = acc[nt][mt][3];
                        if (j >= 64 && !ri.isctx) {
                            const int pi = (j - 64) >> 1;
                            const float4 cs = *(const float4*)(ROPE + (ri.t * 16 + pi) * 2);
                            const float y0 = x0 * cs.x - x1 * cs.y, y1 = x0 * cs.y + x1 * cs.x, y2 = x2 * cs.z - x3 * cs.w, y3 = x2 * cs.w + x3 * cs.z;
                            x0 = y0; x1 = y1; x2 = y2; x3 = y3;
                        }
                        uint2 o; o.x = pack2(x0 * QSCALE, x1 * QSCALE); o.y = pack2(x2 * QSCALE, x3 * QSCALE);
                        *(uint2*)(Qb + ((size_t)(ri.b * 8 + hh) * NKEY + idx) * 96 + j) = o;
                    }
                continue;
            }
            gi -= 816;
            {
                const int m0 = (gi >> 3) * 128, n0 = (gi & 7) * 128;
                gemm_core<false>(ls, LA + (size_t)(m0 + (tid >> 2)) * 384 + 256 + (tid & 3) * 8, WTM + WTM_UKV + (size_t)(n0 + (tid >> 2)) * 128 + (tid & 3) * 8, nullptr, 0, 128, acc);
#pragma unroll
                for (int nt = 0; nt < 2; ++nt)
#pragma unroll
                    for (int mt = 0; mt < 4; ++mt) {
                        const int n = n0 + EPI_N(nt), m = m0 + EPI_M(mt);
                        const RowInfo ri = row_info(m);
                        const int hh = n >> 7, j = n & 127, idx = ri.isctx ? 4096 + ri.t : ri.t;
                        if (j < 64) {
                            uint2 o; o.x = pack2(acc[nt][mt][0], acc[nt][mt][1]); o.y = pack2(acc[nt][mt][2], acc[nt][mt][3]);
                            *(uint2*)(Kb + ((size_t)(ri.b * 8 + hh) * NKEY + idx) * 96 + j) = o;
                        } else {
                            u16* vt = VTb + ((size_t)(ri.b * 8 + hh) * 64 + (j - 64)) * NKEY + idx;
                            vt[0] = f2bf(acc[nt][mt][0]); vt[NKEY] = f2bf(acc[nt][mt][1]); vt[2 * NKEY] = f2bf(acc[nt][mt][2]); vt[3 * NKEY] = f2bf(acc[nt][mt][3]);
                        }
                    }
            }
        }
        xcd_barrier(bar); STAMP(3 + l * 9 + 2);
        REFRESH();
        if (bid < 128) { rwkv_scan_block(bid, WD, KK, KKA, KVEC, RR, RV, OFB, lf); STAMP(40 + l); }
        {
            const int nAttL = 512, nAttC = last ? 0 : 32, nMl = 1024, nMc = last ? 0 : 64;
            const int total = nAttL + nAttC + nMl + nMc;
            for (;;) {
                __syncthreads();
                if (tid == 0) misc[0] = (int)atomicAdd(&CTL[CW_QUEUE(l)], 1u);
                __syncthreads();
                int it = misc[0];
                if (it >= total) break;
#if PROF
                const unsigned long long tq0 = __builtin_amdgcn_s_memrealtime();
                const int itq = it;
#endif
                if (it < nAttL) { const int b = it >> 7, h = (it >> 4) & 7, qt = it & 15; attn_item(b, h, qt * 256, 0, 68, b * 4096 + qt * 256, Qb, Kb, VTb, MIX, ls); }
                else if (it < nAttL + nAttC) { it -= nAttL; const int b = it >> 3, h = it & 7; attn_item(b, h, 4096, 4096, 4, RL + b * 256, Qb, Kb, VTb, MIX, ls); }
                else if (it < nAttL + nAttC + nMl) { it -= nAttL + nAttC; const int b = it >> 8, h = (it >> 6) & 3, tb = 4 + (it & 63); mlstm_out_item(p, l, b, h, tb, Z, MQ, MK, GL, CLOC, MIX, lf); }
                else { it -= nAttL + nAttC + nMl; const int b = it >> 4, h = (it >> 2) & 3, tb = it & 3; mlstm_out_item(p, l, b, h, tb, Z, MQ, MK, GL, CLOC, MIX, lf); }
#if PROF
                if (bid == G - 1 && tid == 0) { unsigned long long* ts = (unsigned long long*)(CTL + CW_TS); ts[(itq < nAttL + nAttC ? 44 : 48) + l] += __builtin_amdgcn_s_memrealtime() - tq0; }
#endif
            }
        }
        xcd_barrier(bar); STAMP(3 + l * 9 + 3);
        REFRESH();
        for (int r = bid * 8 + wv; r < Rl; r += G * 8) {
            float o4[4], rv4[4], kv4[4], vv4[4], gg4[4];
#pragma unroll
            for (int hh = 0; hh < 4; ++hh) {
                const int c = hh * 64 + lane;
                o4[hh] = OFB[(size_t)r * 256 + c] + OFB[((size_t)RT + r) * 256 + c];
                rv4[hh] = bf2f(RR[(size_t)r * 256 + c]);
                kv4[hh] = bf2f(KVEC[(size_t)r * 256 + c]) + bf2f(KVEC[((size_t)RT + r) * 256 + c]);
                vv4[hh] = bf2f(RV[(size_t)r * 256 + c]); gg4[hh] = bf2f(GG[(size_t)r * 256 + c]);
            }
#pragma unroll
            for (int hh = 0; hh < 4; ++hh) {
                const int c = hh * 64 + lane;
                const float mean = wave_sum(o4[hh]) * (1.f / 64.f);
                const float dd = o4[hh] - mean;
                const float rstd = rsqrtf(wave_sum(dd * dd) * (1.f / 64.f) + 64e-5f);
                const float bs = wave_sum(rv4[hh] * PIN(18)[l * 256 + c] * kv4[hh]);
                const float hn = dd * rstd * PIN(19)[l * 256 + c] + PIN(20)[l * 256 + c] + bs * vv4[hh];
                MIX[(size_t)r * 1024 + 256 + c] = f2bf(hn * gg4[hh]);
            }
        }
        xcd_barrier(bar); STAMP(3 + l * 9 + 4);
        REFRESH();
        for (int it = bid; it < (Rl / 256) * 4; it += G) {
            const int m0 = (it >> 2) * 256, n0 = (it & 3) * 256;
            G_IDS
            unsigned aoff[2], boff[2];
#pragma unroll
            for (int i = 0; i < 2; ++i) { G_PIECE(i, R, C); aoff[i] = ((unsigned)(m0 + R) * 1024u + C) * 2u; boff[i] = ((unsigned)(n0 + R) * 1024u + C) * 2u; }
            f32x4 acc[2][2][4][2];
            gemm256_tile<false>(ls, MIX, aoff, aoff, 128u * 1024u, WTM + WTM_WOUT, boff, 128u * 1024u, 1024, acc, tid, wr, wc, fr, fq);
#pragma unroll
            for (int ai = 0; ai < 2; ++ai)
#pragma unroll
                for (int bj = 0; bj < 2; ++bj)
#pragma unroll
                    for (int m = 0; m < 4; ++m)
#pragma unroll
                        for (int n = 0; n < 2; ++n) {
                            const int row = m0 + G_ROW(ai, m), col = n0 + G_COL(bj, n);
                            *(float4*)(Y + (size_t)row * 1024 + col) = make_float4(acc[ai][bj][m][n][0], acc[ai][bj][m][n][1], acc[ai][bj][m][n][2], acc[ai][bj][m][n][3]);
                        }
            asm volatile("s_waitcnt vmcnt(0)" ::: "memory");
        }
        xcd_barrier(bar); STAMP(3 + l * 9 + 5);
        REFRESH();
        {
            const int rpb = (Rl + G - 1) / G;
            const int r0 = bid * rpb, r1 = min(Rl, r0 + rpb), nrows = max(0, r1 - r0);
            float* H2s = lf;
            float* Pp = lf + 16 * 1028;
            int* lcnt = (int*)(Pp + 8192);
            int* lbase = lcnt + 64;
            int* srec_e = lbase + 64;
            int* srec_p = srec_e + 1024;
            float* srec_g = (float*)(srec_p + 1024);
            if (tid < 64) lcnt[tid] = 0;
            __syncthreads();
            const int g4 = lane >> 4, li = lane & 15;
#pragma unroll 1
            for (int ps = 0; ps * 16 < nrows; ++ps) {
#pragma unroll 1
                for (int i2 = 0; i2 < 2; ++i2) {
                    const int rl = ps * 16 + 2 * wv + i2, r = r0 + rl;
                    float4 a[4];
                    if (rl < nrows) {
                        const RowInfo ri = row_info(r);
                        const float* xr = (l == 0) ? (ri.isctx ? ctx_in + (size_t)(r - RL) * 1024 : x_in + (size_t)r * 1024) : (ri.isctx ? XC + (size_t)(r - RL) * 1024 : OUT + (size_t)r * 1024);
                        float* xw = ri.isctx ? XC + (size_t)(r - RL) * 1024 : OUT + (size_t)r * 1024;
                        const float* md = MOD + (l * 5 + ri.mi) * 6144;
                        float4 y[4]; row_load(xr, lane, a); row_load(Y + (size_t)r * 1024, lane, y);
#pragma unroll
                        for (int i = 0; i < 4; ++i) {
                            const float4 gt = *(const float4*)(md + 2048 + (i * 64 + lane) * 4);
                            a[i].x = ALPHA * a[i].x + gt.x * y[i].x; a[i].y = ALPHA * a[i].y + gt.y * y[i].y; a[i].z = ALPHA * a[i].z + gt.z * y[i].z; a[i].w = ALPHA * a[i].w + gt.w * y[i].w;
                        }
                        row_ln(a); row_affine(a, PIN(26) + l * 1024, PIN(27) + l * 1024, lane, 0.f);
                        row_store_f32(xw, lane, a);
                        row_ln(a); row_affine(a, md + 4096, md + 3072, lane, 1.f);
                        row_store_bf16(H + (size_t)r * 1024, lane, a);
                    } else {
#pragma unroll
                        for (int i = 0; i < 4; ++i) a[i] = make_float4(0.f, 0.f, 0.f, 0.f);
                    }
                    row_store_f32(H2s + (2 * wv + i2) * 1028, lane, a);
                }
                __syncthreads();
                {
                    f32x4 acc[4];
#pragma unroll
                    for (int t = 0; t < 4; ++t) acc[t] = (f32x4){0.f, 0.f, 0.f, 0.f};
                    const float* rw = PIN(28) + (size_t)l * 1024 * 64 + 4 * li;
#pragma unroll 2
                    for (int j = 0; j < 8; ++j) {
                        const int kb = wv * 128 + j * 16 + 4 * g4;
                        const float4 av = *(const float4*)(H2s + li * 1028 + kb);
                        const float4 b0 = *(const float4*)(rw + (size_t)(kb + 0) * 64), b1 = *(const float4*)(rw + (size_t)(kb + 1) * 64);
                        const float4 b2 = *(const float4*)(rw + (size_t)(kb + 2) * 64), b3 = *(const float4*)(rw + (size_t)(kb + 3) * 64);
                        acc[0] = __builtin_amdgcn_mfma_f32_16x16x4f32(av.x, b0.x, acc[0], 0, 0, 0); acc[1] = __builtin_amdgcn_mfma_f32_16x16x4f32(av.x, b0.y, acc[1], 0, 0, 0);
                        acc[2] = __builtin_amdgcn_mfma_f32_16x16x4f32(av.x, b0.z, acc[2], 0, 0, 0); acc[3] = __builtin_amdgcn_mfma_f32_16x16x4f32(av.x, b0.w, acc[3], 0, 0, 0);
                        acc[0] = __builtin_amdgcn_mfma_f32_16x16x4f32(av.y, b1.x, acc[0], 0, 0, 0); acc[1] = __builtin_amdgcn_mfma_f32_16x16x4f32(av.y, b1.y, acc[1], 0, 0, 0);
                        acc[2] = __builtin_amdgcn_mfma_f32_16x16x4f32(av.y, b1.z, acc[2], 0, 0, 0); acc[3] = __builtin_amdgcn_mfma_f32_16x16x4f32(av.y, b1.w, acc[3], 0, 0, 0);
                        acc[0] = __builtin_amdgcn_mfma_f32_16x16x4f32(av.z, b2.x, acc[0], 0, 0, 0); acc[1] = __builtin_amdgcn_mfma_f32_16x16x4f32(av.z, b2.y, acc[1], 0, 0, 0);
                        acc[2] = __builtin_amdgcn_mfma_f32_16x16x4f32(av.z, b2.z, acc[2], 0, 0, 0); acc[3] = __builtin_amdgcn_mfma_f32_16x16x4f32(av.z, b2.w, acc[3], 0, 0, 0);
                        acc[0] = __builtin_amdgcn_mfma_f32_16x16x4f32(av.w, b3.x, acc[0], 0, 0, 0); acc[1] = __builtin_amdgcn_mfma_f32_16x16x4f32(av.w, b3.y, acc[1], 0, 0, 0);
                        acc[2] = __builtin_amdgcn_mfma_f32_16x16x4f32(av.w, b3.z, acc[2], 0, 0, 0); acc[3] = __builtin_amdgcn_mfma_f32_16x16x4f32(av.w, b3.w, acc[3], 0, 0, 0);
                    }
#pragma unroll
                    for (int reg = 0; reg < 4; ++reg)
                        *(float4*)(Pp + (wv * 16 + 4 * g4 + reg) * 64 + 4 * li) = make_float4(acc[0][reg], acc[1][reg], acc[2][reg], acc[3][reg]);
                }
                __syncthreads();
#pragma unroll 1
                for (int i2 = 0; i2 < 2; ++i2) {
                    const int rl = ps * 16 + 2 * wv + i2;
                    if (rl >= nrows) continue;
                    float lg = 0.f;
#pragma unroll
                    for (int w2 = 0; w2 < 8; ++w2) lg += Pp[(w2 * 16 + 2 * wv + i2) * 64 + lane];
                    const float score = sigm(lg), biased = score + PIN(29)[l * 64 + lane];
                    float m1 = biased; m1 = fmaxf(m1, __shfl_xor(m1, 1)); m1 = fmaxf(m1, __shfl_xor(m1, 2)); m1 = fmaxf(m1, __shfl_xor(m1, 4));
                    const unsigned long long eq = __ballot(biased == m1);
                    const int grp = lane >> 3;
                    const int idx1 = __builtin_ctz((unsigned)((eq >> (grp * 8)) & 0xffull));
                    float v2 = ((lane & 7) == idx1) ? -INFINITY : biased;
                    v2 = fmaxf(v2, __shfl_xor(v2, 1)); v2 = fmaxf(v2, __shfl_xor(v2, 2)); v2 = fmaxf(v2, __shfl_xor(v2, 4));
                    const float gs = m1 + v2;
                    int grank = 0;
#pragma unroll
                    for (int j = 0; j < 8; ++j) { const float gj = __shfl(gs, j * 8); grank += (gj > gs || (gj == gs && j < grp)) ? 1 : 0; }
                    const float masked = (grank < 4) ? biased : -INFINITY;
                    int rank = 0;
                    for (int j = 0; j < 64; ++j) { const float vj = __shfl(masked, j); rank += (vj > masked || (vj == masked && j < lane)) ? 1 : 0; }
                    const bool sel = rank < 8;
                    const float ssum = wave_sum(sel ? score : 0.f);
                    if (sel) {
                        const int lp = atomicAdd(&lcnt[lane], 1);
                        srec_e[rl * 8 + rank] = lane; srec_p[rl * 8 + rank] = lp; srec_g[rl * 8 + rank] = 2.5f * score / ssum;
                    }
                }
                __syncthreads();
            }
            if (tid < 64) lbase[tid] = (int)atomicAdd(&CTL[CW_CNT(l) + tid], (unsigned)lcnt[tid]);
            __syncthreads();
            for (int i = tid; i < nrows * 8; i += 512) {
                const int e = srec_e[i], pos = lbase[e] + srec_p[i], r = r0 + (i >> 3);
                TOK[(size_t)e * RT + pos] = r; GATE[(size_t)e * RT + pos] = srec_g[i]; SLOT[(size_t)r * 8 + (i & 7)] = (e << 20) | pos;
            }
            __syncthreads();
            for (int it = bid; it < N_CONV_MOE; it += G) conv_moe_item(p, l, it, WTE, ls);
        }
        xcd_barrier(bar); STAMP(3 + l * 9 + 6);
        REFRESH();
        {
            int* pre = (int*)(lds + LDS_BYTES - 1024);
            if (tid == 0) {
                int a = 0, o = 0;
                for (int e = 0; e < 64; ++e) { const int c = (int)CTL[CW_CNT(l) + e]; pre[e] = a; pre[66 + e] = o; a += (c + 255) >> 8; o += c; }
                pre[64] = a; pre[66 + 64] = SH_SLOT; a += Rl / 256; pre[65] = a;
            }
            __syncthreads();
            const int nmt = pre[65];
            for (int it = bid; it < nmt * 2; it += G) {
                const int im = it >> 1, n0 = (it & 1) * 256;
                int e = 0;
                while (pre[e + 1] <= im) ++e;
                const int mtile = im - pre[e];
                const int cnt = (e < 64) ? (int)CTL[CW_CNT(l) + e] : Rl;
                const int nvalid = min(256, cnt - mtile * 256);
                const int slot0 = pre[66 + e] + mtile * 256;
                G_IDS
                unsigned aoff[2], aoff1[2], boff[2];
#pragma unroll
                for (int i = 0; i < 2; ++i) {
                    G_PIECE(i, R, C);
                    const int r0 = (R < nvalid) ? R : 0, r1 = (R + 128 < nvalid) ? R + 128 : 0;
                    const int t0 = (e < 64) ? TOK[(size_t)e * RT + mtile * 256 + r0] : mtile * 256 + r0;
                    const int t1 = (e < 64) ? TOK[(size_t)e * RT + mtile * 256 + r1] : mtile * 256 + r1;
                    aoff[i] = ((unsigned)t0 * 1024u + C) * 2u; aoff1[i] = ((unsigned)t1 * 1024u + C) * 2u;
                    boff[i] = ((unsigned)(n0 + R) * 1024u + C) * 2u;
                }
                f32x4 acc[2][2][4][2];
                gemm256_tile<true>(ls, H, aoff, aoff1, 0u, WTE + (size_t)e * WTE_PER, boff, 128u * 1024u, 1024, acc, tid, wr, wc, fr, fq);
#pragma unroll
                for (int ai = 0; ai < 2; ++ai)
#pragma unroll
                    for (int m = 0; m < 4; ++m) {
                        const int row = G_ROW(ai, m);
                        if (row < nvalid) {
#pragma unroll
                            for (int bj = 0; bj < 2; ++bj) {
                                float a0 = acc[ai][bj][m][0][0], a1 = acc[ai][bj][m][0][1], a2 = acc[ai][bj][m][0][2], a3 = acc[ai][bj][m][0][3];
                                a0 = a0 / (1.f + __expf(-a0)) * acc[ai][bj][m][1][0]; a1 = a1 / (1.f + __expf(-a1)) * acc[ai][bj][m][1][1];
                                a2 = a2 / (1.f + __expf(-a2)) * acc[ai][bj][m][1][2]; a3 = a3 / (1.f + __expf(-a3)) * acc[ai][bj][m][1][3];
                                uint2 o; o.x = pack2(a0, a1); o.y = pack2(a2, a3);
                                *(uint2*)(ACT + (size_t)(slot0 + row) * 256 + (n0 >> 1) + bj * 64 + wc * 16 + fq * 4) = o;
                            }
                        }
                    }
                asm volatile("s_waitcnt vmcnt(0)" ::: "memory");
            }
        }
        xcd_barrier(bar);
        REFRESH();
        {
            int* pre = (int*)(lds + LDS_BYTES - 1024);
            if (tid == 0) {
                int a = 0, o = 0;
                for (int e = 0; e < 64; ++e) { const int c = (int)CTL[CW_CNT(l) + e]; pre[e] = a; pre[66 + e] = o; a += (c + 255) >> 8; o += c; }
                pre[64] = a; pre[66 + 64] = SH_SLOT; a += Rl / 256; pre[65] = a;
            }
            __syncthreads();
            const int nmt = pre[65];
            for (int it = bid; it < nmt * 4; it += G) {
                const int im = it >> 2, n0 = (it & 3) * 256;
                int e = 0;
                while (pre[e + 1] <= im) ++e;
                const int mtile = im - pre[e];
                const int cnt = (e < 64) ? (int)CTL[CW_CNT(l) + e] : Rl;
                const int nvalid = min(256, cnt - mtile * 256);
                const int slot0 = pre[66 + e] + mtile * 256;
                G_IDS
                unsigned aoff[2], boff[2];
#pragma unroll
                for (int i = 0; i < 2; ++i) { G_PIECE(i, R, C); aoff[i] = ((unsigned)(slot0 + R) * 256u + C) * 2u; boff[i] = ((unsigned)(n0 + R) * 256u + C) * 2u; }
                f32x4 acc[2][2][4][2];
                gemm256_tile<false>(ls, ACT, aoff, aoff, 128u * 256u, WTE + (size_t)e * WTE_PER + 512 * 1024, boff, 128u * 256u, 256, acc, tid, wr, wc, fr, fq);
#pragma unroll
                for (int ai = 0; ai < 2; ++ai)
#pragma unroll
                    for (int m = 0; m < 4; ++m) {
                        const int row = G_ROW(ai, m);
                        if (row < nvalid) {
                            const float gt = (e < 64) ? GATE[(size_t)e * RT + mtile * 256 + row] : 1.f;
#pragma unroll
                            for (int bj = 0; bj < 2; ++bj)
#pragma unroll
                                for (int n = 0; n < 2; ++n) {
                                    uint2 o; o.x = pack2(acc[ai][bj][m][n][0] * gt, acc[ai][bj][m][n][1] * gt); o.y = pack2(acc[ai][bj][m][n][2] * gt, acc[ai][bj][m][n][3] * gt);
                                    *(uint2*)(YEXP + (size_t)(slot0 + row) * 1024 + n0 + G_COL(bj, n)) = o;
                                }
                        }
                    }
                asm volatile("s_waitcnt vmcnt(0)" ::: "memory");
            }
        }
        xcd_barrier(bar); STAMP(3 + l * 9 + 7);
        REFRESH();
        {
            int* off = (int*)(lds + LDS_BYTES - 1024);
            if (tid == 0) { int o = 0; for (int e = 0; e < 64; ++e) { off[e] = o; o += (int)CTL[CW_CNT(l) + e]; } }
            __syncthreads();
            for (int r = bid * 8 + wv; r < Rl; r += G * 8) {
                const RowInfo ri = row_info(r);
                float* xw = ri.isctx ? XC + (size_t)(r - RL) * 1024 : OUT + (size_t)r * 1024;
                const float* md = MOD + (l * 5 + ri.mi) * 6144;
                float4 f[4];
#pragma unroll
                for (int i = 0; i < 4; ++i) f[i] = make_float4(0.f, 0.f, 0.f, 0.f);
                int myslot = SH_SLOT + r;
                if (lane < 8) { const int sv = SLOT[(size_t)r * 8 + lane]; myslot = off[sv >> 20] + (sv & 0xfffff); }
#pragma unroll
                for (int j0 = 0; j0 < 9; j0 += 3) {
                    uint2 v[3][4];
#pragma unroll
                    for (int jj = 0; jj < 3; ++jj) {
                        const int slot = __shfl(myslot, j0 + jj);
                        const u16* yr = YEXP + (size_t)slot * 1024;
#pragma unroll
                        for (int i = 0; i < 4; ++i) v[jj][i] = *(const uint2*)(yr + (i * 64 + lane) * 4);
                    }
#pragma unroll
                    for (int jj = 0; jj < 3; ++jj)
#pragma unroll
                        for (int i = 0; i < 4; ++i) {
                            f[i].x += __uint_as_float(v[jj][i].x << 16); f[i].y += __uint_as_float(v[jj][i].x & 0xffff0000u); f[i].z += __uint_as_float(v[jj][i].y << 16); f[i].w += __uint_as_float(v[jj][i].y & 0xffff0000u);
                        }
                }
                float4 a[4]; row_load(xw, lane, a);
#pragma unroll
                for (int i = 0; i < 4; ++i) {
                    const float4 gt = *(const float4*)(md + 5120 + (i * 64 + lane) * 4);
                    a[i].x = ALPHA * a[i].x + gt.x * f[i].x; a[i].y = ALPHA * a[i].y + gt.y * f[i].y; a[i].z = ALPHA * a[i].z + gt.z * f[i].z; a[i].w = ALPHA * a[i].w + gt.w * f[i].w;
                }
                row_ln(a); row_affine(a, PIN(36) + l * 1024, PIN(37) + l * 1024, lane, 0.f);
                row_store_f32(xw, lane, a);
                if (!last) {
                    const float* md2 = MOD + ((l + 1) * 5 + ri.mi) * 6144;
                    row_ln(a); row_affine(a, md2 + 1024, md2, lane, 1.f);
                    row_store_bf16(H + (size_t)r * 1024, lane, a);
                }
            }
            if (!last) for (int it = bid; it < N_CONV_MIXER; it += G) conv_mixer_item(p, l + 1, it, WTM, ls);
            __syncthreads();
        }
        if (!last || PROF) { xcd_barrier(bar); STAMP(3 + l * 9 + 8); }
    }
#if PROF
    {
        xcd_barrier(bar);
        REFRESH();
        const unsigned long long* ts = (const unsigned long long*)(CTL + CW_TS);
        const float tot = (float)(ts[20] - ts[0]);
        auto frac = [&](int q) -> float {
            if (q == 0) return (float)(ts[1] - ts[0]) / tot;
            if (q == 1) return (float)(ts[2] - ts[1]) / tot;
            if (q == 11) return (float)((ts[40] - ts[5]) + (ts[41] - ts[14])) / tot;
            if (q == 12) return (float)(ts[44] + ts[45]) / tot;
            if (q == 13) return (float)(ts[48] + ts[49]) / tot;
            const int j = q - 2;
            return (float)((ts[3 + j] - ts[2 + j]) + (ts[12 + j] - ts[11 + j])) / tot;
        };
        const float f1 = frac(PROF_A), f2 = frac(PROF_B);
        const float sc = 1.f + sqrtf(3e-4f * f1);
        for (int r = bid * 8 + wv; r < RL; r += G * 8) {
            float4 a[4]; row_load(OUT + (size_t)r * 1024, lane, a);
#pragma unroll
            for (int i = 0; i < 4; ++i) { a[i].x *= sc; a[i].y *= sc; a[i].z *= sc; a[i].w *= sc; }
            if (r == 0 && lane == 0) a[0].x += 1.f + 8.9f * f2;
            row_store_f32(OUT + (size_t)r * 1024, lane, a);
        }
    }
#endif
}

extern "C" void kernel_launch(void* const* d_in, const int* in_sizes, int n_in, void* d_out, int out_size, void* d_ws, size_t ws_size, hipStream_t stream) {
    static int grid = 0;
    if (grid == 0) {
        int dev = 0, cus = 0, per_cu = 0;
        hipGetDevice(&dev);
        hipDeviceGetAttribute(&cus, hipDeviceAttributeMultiprocessorCount, dev);
        hipOccupancyMaxActiveBlocksPerMultiprocessor(&per_cu, (const void*)mega, 512, 0);
        (void)hipGetLastError();
        grid = (per_cu >= 1 && cus >= 256) ? 256 : -1;
        if (n_in != 38 || ws_size < WS_NEED) grid = -1;
        if (grid < 0) fprintf(stderr, "kernel_launch: cannot run (cus %d, per_cu %d, n_in %d, ws %zu need %zu)\n", cus, per_cu, n_in, ws_size, (size_t)WS_NEED);
    }
    if (grid < 0) return;
    hipMemsetAsync((char*)d_ws + OFF_CTL, 0, 65536, stream);
    Params p{};
    for (int i = 0; i < 38; ++i) p.in[i] = (const float*)d_in[i];
    p.out = (float*)d_out; p.ws = (unsigned char*)d_ws;
    hipLaunchKernelGGL(mega, dim3(grid), dim3(512), 0, stream, p);
}
```

```cpp
#include <hip/hip_runtime.h>
#include <stdint.h>
#include <stdio.h>

typedef unsigned short u16;
typedef __attribute__((ext_vector_type(8))) short bf16x8;
typedef __attribute__((ext_vector_type(4))) float f32x4;
#define DEVI __device__ __forceinline__
#define LAS __attribute__((address_space(3)))

#define DM 1024
#define TL 4096
#define TC 256
#define RL 16384
#define RT 17408
#define NIN 2608
#define ZC_MV 512
#define ZC_MO 768
#define ZC_MG 1024
#define ZC_RW 1040
#define ZC_MLA 2192
#define NKEY 4352
#define ALPHA 1.41421356237309515f
#define QSCALE (0.10206207261596575f * 1.4426950408889634f)
#define CREC 4224
#define SH_SLOT 139264

constexpr size_t OFF_CTL  = 0;
constexpr size_t OFF_MOD  = 65536;
constexpr size_t OFF_ROPE = OFF_MOD + 245760;
constexpr size_t OFF_XC   = OFF_ROPE + 524288;
constexpr size_t OFF_WTM  = OFF_XC + 4194304;
constexpr size_t WTM_WIN = 0, WTM_UQ = WTM_WIN + (size_t)2816 * 1024, WTM_UKV = WTM_UQ + 768 * 256, WTM_WUP = WTM_UKV + 1024 * 128,
                 WTM_AUP = WTM_WUP + 2 * 256 * 64, WTM_GUP = WTM_AUP + 2 * 256 * 64, WTM_WOUT = WTM_GUP + 256 * 128, WTM_END = WTM_WOUT + 1024 * 1024;
constexpr size_t OFF_H    = OFF_WTM + ((WTM_END * 2 + 255) & ~(size_t)255);
constexpr size_t OFF_S    = OFF_H + (size_t)RT * 1024 * 2;
constexpr size_t S_Z    = OFF_S;
constexpr size_t S_MQ   = S_Z + (size_t)RT * NIN * 2;
constexpr size_t S_MK   = S_MQ + (size_t)RT * 256 * 2;
constexpr size_t S_GL   = S_MK + (size_t)RT * 256 * 2;
constexpr size_t S_CLOC = S_GL + (size_t)RT * 16 * 4;
constexpr size_t S_WD   = S_CLOC + (size_t)32 * 68 * CREC * 4;
constexpr size_t S_KK   = S_WD + (size_t)2 * RT * 256 * 4;
constexpr size_t S_KKA  = S_KK + (size_t)RT * 256 * 2;
constexpr size_t S_KVEC = S_KKA + (size_t)2 * RT * 256 * 2;
constexpr size_t S_RR   = S_KVEC + (size_t)2 * RT * 256 * 2;
constexpr size_t S_RV   = S_RR + (size_t)RT * 256 * 2;
constexpr size_t S_RK   = S_RV + (size_t)RT * 256 * 2;
constexpr size_t S_G    = S_RK + (size_t)RT * 256 * 2;
constexpr size_t S_LI   = S_G + (size_t)RT * 256 * 2;
constexpr size_t S_LA   = S_LI + (size_t)RT * 384 * 2;
constexpr size_t S_OF   = S_LA + (size_t)RT * 384 * 2;
constexpr size_t S_Q    = S_OF + (size_t)2 * RT * 256 * 4;
constexpr size_t S_K    = S_Q + (size_t)32 * NKEY * 96 * 2;
constexpr size_t S_VT   = S_K + (size_t)32 * NKEY * 96 * 2;
constexpr size_t S_MIX_END = S_VT + (size_t)32 * 64 * NKEY * 2;
constexpr size_t CH_SZ = (size_t)2176 * 4096 * 2;
constexpr size_t S_CW  = S_LI;
constexpr size_t S_CGL = S_CW + CH_SZ;
constexpr size_t S_CVT = S_MIX_END;
constexpr size_t S_CMB = S_CVT + CH_SZ;
constexpr size_t S_CMQ = S_CMB + CH_SZ;
constexpr size_t S_CX2 = S_CMQ + CH_SZ;
constexpr size_t S_CBH = S_CX2 + CH_SZ;
constexpr size_t S_CQH = S_CBH + CH_SZ;
constexpr size_t S_CH_END = S_CQH + CH_SZ;
static_assert(S_CGL + 2176 * 64 * 4 <= S_OF, "chunk arrays overflow the LI/LA region");
constexpr size_t S_YEXP = OFF_S;
constexpr size_t S_Y    = OFF_S;
constexpr size_t S_WTE  = S_YEXP + (size_t)(SH_SLOT + RT) * 1024 * 2;
constexpr size_t WTE_PER = 786432;
constexpr size_t S_TOK  = S_WTE + (size_t)65 * WTE_PER * 2;
constexpr size_t S_GATE = S_TOK + (size_t)64 * RT * 4;
constexpr size_t S_SLOT = S_GATE + (size_t)64 * RT * 4;
constexpr size_t S_ACT  = S_SLOT + (size_t)RT * 8 * 4;
constexpr size_t S_MOE_END = S_ACT + (size_t)(SH_SLOT + RT) * 256 * 2;
constexpr size_t WS_NEED = (S_CH_END > S_MOE_END ? S_CH_END : S_MOE_END);

#define CW_QUEUE(l) (4096 + 64 * (l))
#define CW_CNT(l)   (4352 + 64 * (l))
#define LDS_BYTES 139264

#ifndef PROF
#define PROF 0
#endif
#ifndef PROF_A
#define PROF_A 0
#endif
#ifndef PROF_B
#define PROF_B 1
#endif
#define CW_TS 8192
struct Params { const float* in[38]; float* out; unsigned char* ws; };

typedef const __attribute__((address_space(1))) float* KArgPtr;
DEVI const float* pin_(int i) {
    const __attribute__((address_space(4))) KArgPtr* tab = (const __attribute__((address_space(4))) KArgPtr*)__builtin_amdgcn_kernarg_segment_ptr();
    asm volatile("" : "+s"(i));
    KArgPtr q = tab[i];
    return (const float*)q;
}
#define PIN(i) pin_(i)
DEVI int TID() { int t = threadIdx.x; asm volatile("" : "+v"(t)); return t; }
DEVI void lds_barrier() { asm volatile("s_waitcnt lgkmcnt(0)" ::: "memory"); __builtin_amdgcn_s_barrier(); asm volatile("" ::: "memory"); }
DEVI float bf2f(u16 v) { return __uint_as_float(((unsigned)v) << 16); }
DEVI u16 f2bf(float f) { unsigned u = __float_as_uint(f); u += 0x7fffu + ((u >> 16) & 1u); return (u16)(u >> 16); }
typedef float f32x2_t __attribute__((ext_vector_type(2)));
typedef __bf16 bf16x2_t __attribute__((ext_vector_type(2)));
DEVI unsigned pack2(float a, float b) { f32x2_t v = {a, b}; bf16x2_t r = __builtin_convertvector(v, bf16x2_t); return __builtin_bit_cast(unsigned, r); }
DEVI float xrow16_max(float x) {
    auto s = __builtin_amdgcn_permlane16_swap(__float_as_uint(x), __float_as_uint(x), false, false);
    x = fmaxf(__uint_as_float(s[0]), __uint_as_float(s[1]));
    auto t = __builtin_amdgcn_permlane32_swap(__float_as_uint(x), __float_as_uint(x), false, false);
    return fmaxf(__uint_as_float(t[0]), __uint_as_float(t[1]));
}
DEVI float xrow16_sum(float x) {
    auto s = __builtin_amdgcn_permlane16_swap(__float_as_uint(x), __float_as_uint(x), false, false);
    x = __uint_as_float(s[0]) + __uint_as_float(s[1]);
    auto t = __builtin_amdgcn_permlane32_swap(__float_as_uint(x), __float_as_uint(x), false, false);
    return __uint_as_float(t[0]) + __uint_as_float(t[1]);
}
DEVI float wave_sum(float v) {
#pragma unroll
    for (int o = 32; o > 0; o >>= 1) v += __shfl_xor(v, o);
    return v;
}
DEVI float wave_max(float v) {
#pragma unroll
    for (int o = 32; o > 0; o >>= 1) v = fmaxf(v, __shfl_xor(v, o));
    return v;
}
DEVI float sigm(float x) { return 1.f / (1.f + __expf(-x)); }
DEVI float logsig(float x) { return fminf(x, 0.f) - __logf(1.f + __expf(-fabsf(x))); }
DEVI float tanh_(float x) { const float e = __expf(2.f * x); return 1.f - 2.f / (e + 1.f); }
template <int CTRL> DEVI float dpp_f(float x) { return __builtin_bit_cast(float, __builtin_amdgcn_update_dpp(0, __builtin_bit_cast(int, x), CTRL, 0xf, 0xf, false)); }
DEVI float red16(float x) {
    x += dpp_f<0xB1>(x); x += dpp_f<0x4E>(x); x += dpp_f<0x141>(x); x += dpp_f<0x140>(x); return x;
}

#define XB_TMO      128
#define XB_XCNT(j)  (256  + 64 * (j))
#define XB_XSUB(j)  (1280 + 64 * (j))
#define XB_XGEN(j)  (2304 + 64 * (j))
#define XB_TOP      3328
#define XB_TOPGEN   3392
#define XB_SPIN_CAP (1u << 27)
DEVI unsigned xb_ld(unsigned* p) { return __hip_atomic_load(p, __ATOMIC_RELAXED, __HIP_MEMORY_SCOPE_AGENT); }
DEVI unsigned xb_add(unsigned* p, unsigned v) { return __hip_atomic_fetch_add(p, v, __ATOMIC_RELAXED, __HIP_MEMORY_SCOPE_AGENT); }
DEVI unsigned xb_xcc_id() { return (unsigned)__builtin_amdgcn_s_getreg((3 << 11) | 20) & 0xFu; }
#define XB_SPIN(cond, bar) do { unsigned _sp = 0; while (cond) { __builtin_amdgcn_s_sleep(2); \
    if ((++_sp & 1023u) == 0u) { if (xb_ld(&(bar)[XB_TMO])) break; if (_sp > XB_SPIN_CAP) { atomicAdd(&(bar)[XB_TMO], 1u); break; } } } } while (0)
struct XcdBarrier { unsigned* bar; unsigned x; volatile LAS unsigned* st; };
DEVI XcdBarrier xcd_barrier_post(unsigned* bar, volatile LAS unsigned* st) {
    XcdBarrier b; b.bar = bar; b.x = 0; b.st = st;
    if (threadIdx.x == 0) { const unsigned x = xb_xcc_id(); st[2] = x; (void)xb_add(&bar[XB_XCNT(x)], 1u); }
    return b;
}
DEVI void xcd_barrier_complete(unsigned* bar, unsigned x, unsigned& nloc, unsigned& nx) {
    const unsigned G = gridDim.x;
    unsigned sum, cnt, mine, sp = 0u;
    for (;;) {
        sum = 0u; cnt = 0u; mine = 0u;
#pragma unroll
        for (unsigned j = 0; j < 16; ++j) { const unsigned c = xb_ld(&bar[XB_XCNT(j)]); sum += c; cnt += (c > 0u) ? 1u : 0u; mine = (j == x) ? c : mine; }
        if (sum == G) break;
        __builtin_amdgcn_s_sleep(2);
        if ((++sp & 1023u) == 0u) { if (xb_ld(&bar[XB_TMO])) break; if (sp > XB_SPIN_CAP) { atomicAdd(&bar[XB_TMO], 1u); break; } }
    }
    nloc = mine > 0u ? mine : 1u; nx = cnt > 0u ? cnt : 1u;
}
DEVI void xcd_barrier(const XcdBarrier& b) {
    asm volatile("s_waitcnt vmcnt(0)" ::: "memory");
    __syncthreads();
    if (threadIdx.x == 0) {
        unsigned* bar = b.bar;
        __builtin_amdgcn_s_waitcnt(0);
        unsigned nloc = b.st[0], nx = b.st[1];
        const unsigned bx = b.st[2];
        if (nloc == 0u) { xcd_barrier_complete(bar, bx, nloc, nx); b.st[0] = nloc; b.st[1] = nx; }
        const unsigned old = xb_add(&bar[XB_XSUB(bx)], 1u);
        const unsigned gen = old / nloc;
        if (old + 1u == (gen + 1u) * nloc) {
            __builtin_amdgcn_fence(__ATOMIC_RELEASE, "agent");
            asm volatile("s_waitcnt vmcnt(0)" ::: "memory");
            const unsigned og = xb_add(&bar[XB_TOP], 1u);
            const unsigned tg = og / nx;
            if (og + 1u == (tg + 1u) * nx) xb_add(&bar[XB_TOPGEN], 1u);
            else XB_SPIN(xb_ld(&bar[XB_TOPGEN]) == tg, bar);
            __builtin_amdgcn_fence(__ATOMIC_ACQUIRE, "agent");
            xb_add(&bar[XB_XGEN(bx)], 1u);
            asm volatile("s_waitcnt vmcnt(0)" ::: "memory");
        } else {
            XB_SPIN(xb_ld(&bar[XB_XGEN(bx)]) == gen, bar);
            __builtin_amdgcn_fence(__ATOMIC_ACQUIRE, "agent");
            asm volatile("s_waitcnt vmcnt(0)" ::: "memory");
        }
    }
    __syncthreads();
}

struct RowInfo { int b, t, seglen, isctx, mi; };
DEVI RowInfo row_info(int r) {
    RowInfo ri;
    if (r < RL) { ri.b = r >> 12; ri.t = r & 4095; ri.seglen = TL; ri.isctx = 0; ri.mi = ri.b; }
    else { int q = r - RL; ri.b = q >> 8; ri.t = q & 255; ri.seglen = TC; ri.isctx = 1; ri.mi = 4; }
    return ri;
}
DEVI void row_load(const float* row, int lane, float4 (&a)[4]) {
#pragma unroll
    for (int i = 0; i < 4; ++i) a[i] = *(const float4*)(row + (i * 64 + lane) * 4);
}
DEVI void row_ln(float4 (&a)[4]) {
    float s = 0.f;
#pragma unroll
    for (int i = 0; i < 4; ++i) s += a[i].x + a[i].y + a[i].z + a[i].w;
    const float mean = wave_sum(s) * (1.f / 1024.f);
    float q = 0.f;
#pragma unroll
    for (int i = 0; i < 4; ++i) { a[i].x -= mean; a[i].y -= mean; a[i].z -= mean; a[i].w -= mean; q += a[i].x * a[i].x + a[i].y * a[i].y + a[i].z * a[i].z + a[i].w * a[i].w; }
    const float rstd = rsqrtf(wave_sum(q) * (1.f / 1024.f) + 1e-6f);
#pragma unroll
    for (int i = 0; i < 4; ++i) { a[i].x *= rstd; a[i].y *= rstd; a[i].z *= rstd; a[i].w *= rstd; }
}
DEVI void row_affine(float4 (&a)[4], const float* mul, const float* add, int lane, float mul_plus) {
#pragma unroll
    for (int i = 0; i < 4; ++i) {
        const float4 m = *(const float4*)(mul + (i * 64 + lane) * 4), d = *(const float4*)(add + (i * 64 + lane) * 4);
        a[i].x = a[i].x * (m.x + mul_plus) + d.x; a[i].y = a[i].y * (m.y + mul_plus) + d.y; a[i].z = a[i].z * (m.z + mul_plus) + d.z; a[i].w = a[i].w * (m.w + mul_plus) + d.w;
    }
}
DEVI void row_store_bf16(u16* row, int lane, const float4 (&a)[4]) {
#pragma unroll
    for (int i = 0; i < 4; ++i) { uint2 o; o.x = pack2(a[i].x, a[i].y); o.y = pack2(a[i].z, a[i].w); *(uint2*)(row + (i * 64 + lane) * 4) = o; }
}
DEVI void row_store_f32(float* row, int lane, const float4 (&a)[4]) {
#pragma unroll
    for (int i = 0; i < 4; ++i) *(float4*)(row + (i * 64 + lane) * 4) = a[i];
}

#define STG_A 0
#define STG_B 5120
#define STG_BUF 10240
template <bool A_LDS>
DEVI void gemm_core(u16* stage, const u16* pa, const u16* pb, const u16* aLds, int aStride, int K, f32x4 (&acc)[2][4]) {
    const int tid = TID(), lane = tid & 63, w = tid >> 6, wm = w >> 2, wn = w & 3, g = lane >> 4, li = lane & 15;
    const int ldrow = tid >> 2, ldseg = tid & 3;
#pragma unroll
    for (int nt = 0; nt < 2; ++nt)
#pragma unroll
        for (int mt = 0; mt < 4; ++mt) acc[nt][mt] = (f32x4){0.f, 0.f, 0.f, 0.f};
    uint4 ra = make_uint4(0, 0, 0, 0), rb = make_uint4(0, 0, 0, 0);
    if (!A_LDS) { if (pa) ra = *(const uint4*)(pa); }
    if (pb) rb = *(const uint4*)(pb);
    if (!A_LDS) *(uint4*)(stage + STG_A + ldrow * 40 + ldseg * 8) = ra;
    *(uint4*)(stage + STG_B + ldrow * 40 + ldseg * 8) = rb;
    lds_barrier();
    const int nk = K >> 5;
    for (int kt = 0; kt < nk; ++kt) {
        const int bsel = kt & 1;
        if (kt + 1 < nk) {
            if (!A_LDS) { if (pa) ra = *(const uint4*)(pa + (kt + 1) * 32); }
            if (pb) rb = *(const uint4*)(pb + (kt + 1) * 32);
        }
        const u16* As = A_LDS ? (aLds + kt * 32) : (stage + bsel * STG_BUF + STG_A);
        const int as = A_LDS ? aStride : 40;
        const u16* Bs = stage + bsel * STG_BUF + STG_B;
        bf16x8 af[4], bfr[2];
#pragma unroll
        for (int mt = 0; mt < 4; ++mt) af[mt] = *(const bf16x8*)(As + (wm * 64 + mt * 16 + li) * as + g * 8);
#pragma unroll
        for (int nt = 0; nt < 2; ++nt) bfr[nt] = *(const bf16x8*)(Bs + (wn * 32 + nt * 16 + li) * 40 + g * 8);
#pragma unroll
        for (int nt = 0; nt < 2; ++nt)
#pragma unroll
            for (int mt = 0; mt < 4; ++mt) acc[nt][mt] = __builtin_amdgcn_mfma_f32_16x16x32_bf16(bfr[nt], af[mt], acc[nt][mt], 0, 0, 0);
        if (kt + 1 < nk) {
            if (!A_LDS) *(uint4*)(stage + (bsel ^ 1) * STG_BUF + STG_A + ldrow * 40 + ldseg * 8) = ra;
            *(uint4*)(stage + (bsel ^ 1) * STG_BUF + STG_B + ldrow * 40 + ldseg * 8) = rb;
        }
        lds_barrier();
    }
}
#define EPI_M(mt) (wm * 64 + (mt) * 16 + li)
#define EPI_N(nt) (wn * 32 + (nt) * 16 + 4 * g)
#define EPI_IDS const int tid = TID(), lane = tid & 63, w = tid >> 6, wm = w >> 2, wn = w & 3, g = lane >> 4, li = lane & 15; (void)lane;

DEVI void conv_tile(const float* src, int ldn, int K, int N, u16* dst, int rb, int rs16, int tk, int tn, u16* t) {
    const int k0 = tk * 64, n0 = tn * 64, tid = TID();
    const int kr = tid >> 4, nc = (tid & 15) * 4;
#pragma unroll
    for (int hh = 0; hh < 2; ++hh) {
        const int k = k0 + kr + hh * 32;
        float4 v = make_float4(0.f, 0.f, 0.f, 0.f);
        if (n0 + nc < N) v = *(const float4*)(src + (size_t)k * ldn + n0 + nc);
        t[(nc + 0) * 72 + kr + hh * 32] = f2bf(v.x); t[(nc + 1) * 72 + kr + hh * 32] = f2bf(v.y);
        t[(nc + 2) * 72 + kr + hh * 32] = f2bf(v.z); t[(nc + 3) * 72 + kr + hh * 32] = f2bf(v.w);
    }
    __syncthreads();
    const int n = tid >> 3, ks = (tid & 7) * 8;
    if (n0 + n < N) {
        const uint4 o = *(const uint4*)(t + n * 72 + ks);
        const int nn = n0 + n, row = rb + (nn >> 4) * rs16 + (nn & 15);
        *(uint4*)(dst + (size_t)row * K + k0 + ks) = o;
    }
    __syncthreads();
}
DEVI void conv_tile4(const float* src, int ldn, int K, u16* dst, int rb, int rs16, int tk, int tn4, u16* t) {
    const int k0 = tk * 64, n0 = tn4 * 256, tid = TID();
    const int kr = tid >> 4, nc = (tid & 15) * 4;
    float4 v[4][2];
#pragma unroll
    for (int q = 0; q < 4; ++q)
#pragma unroll
        for (int hh = 0; hh < 2; ++hh) v[q][hh] = *(const float4*)(src + (size_t)(k0 + kr + hh * 32) * ldn + n0 + q * 64 + nc);
#pragma unroll
    for (int q = 0; q < 4; ++q)
#pragma unroll
        for (int hh = 0; hh < 2; ++hh) {
            u16* d = t + (q * 64 + nc) * 72 + kr + hh * 32;
            d[0] = f2bf(v[q][hh].x); d[72] = f2bf(v[q][hh].y); d[144] = f2bf(v[q][hh].z); d[216] = f2bf(v[q][hh].w);
        }
    __syncthreads();
    const int ks = (tid & 7) * 8;
#pragma unroll
    for (int q = 0; q < 4; ++q) {
        const int n = (tid >> 3) + 64 * q;
        const uint4 o = *(const uint4*)(t + n * 72 + ks);
        const int nn = n0 + n, row = rb + (nn >> 4) * rs16 + (nn & 15);
        *(uint4*)(dst + (size_t)row * K + k0 + ks) = o;
    }
    __syncthreads();
}
DEVI void conv_mixer_item(const Params& p, int l, int it, u16* wtm, u16* t) {
    if (it < 656) { conv_tile(PIN(6) + (size_t)l * 1024 * NIN, NIN, 1024, NIN, wtm + WTM_WIN, 0, 16, it / 41, it % 41, t); return; }
    it -= 656;
    if (it < 48) { conv_tile(PIN(23) + (size_t)l * 256 * 768, 768, 256, 768, wtm + WTM_UQ, 0, 16, it / 12, it % 12, t); return; }
    it -= 48;
    if (it < 32) { conv_tile(PIN(24) + (size_t)l * 128 * 1024, 1024, 128, 1024, wtm + WTM_UKV, 0, 16, it / 16, it % 16, t); return; }
    it -= 32;
    if (it < 8) { const int d = it >> 2; conv_tile(PIN(12) + (size_t)(l * 2 + d) * 64 * 256, 256, 64, 256, wtm + WTM_WUP + d * 256 * 64, 0, 16, 0, it & 3, t); return; }
    it -= 8;
    if (it < 8) { const int d = it >> 2; conv_tile(PIN(14) + (size_t)(l * 2 + d) * 64 * 256, 256, 64, 256, wtm + WTM_AUP + d * 256 * 64, 0, 16, 0, it & 3, t); return; }
    it -= 8;
    if (it < 8) { conv_tile(PIN(15) + (size_t)l * 128 * 256, 256, 128, 256, wtm + WTM_GUP, 0, 16, it >> 2, it & 3, t); return; }
    it -= 8;
    conv_tile(PIN(25) + (size_t)l * 1024 * 1024, 1024, 1024, 1024, wtm + WTM_WOUT, 0, 16, it >> 4, it & 15, t);
}
#define N_CONV_MIXER 1016
DEVI void conv_moe_item(int l, int it, u16* wte, u16* t) {
    const int e = it / 48, r = it % 48;
    u16* w1 = wte + (size_t)e * WTE_PER; u16* w2 = w1 + 512 * 1024;
    if (r < 16) {
        const float* src = (e < 64) ? PIN(30) + (size_t)(l * 64 + e) * 1024 * 256 : PIN(33) + (size_t)l * 1024 * 256;
        conv_tile4(src, 256, 1024, w1, 0, 32, r, 0, t);
    } else if (r < 32) {
        const float* src = (e < 64) ? PIN(31) + (size_t)(l * 64 + e) * 1024 * 256 : PIN(34) + (size_t)l * 1024 * 256;
        conv_tile4(src, 256, 1024, w1, 16, 32, r - 16, 0, t);
    } else {
        const float* src = (e < 64) ? PIN(32) + (size_t)(l * 64 + e) * 256 * 1024 : PIN(35) + (size_t)l * 256 * 1024;
        conv_tile4(src, 1024, 256, w2, 0, 16, (r - 32) >> 2, (r - 32) & 3, t);
    }
}
#define N_CONV_MOE 3120

DEVI void phase_mods(const Params& p, float* MOD, float* ROPE, float* ldsf) {
    const int tidx = TID();
    for (int it = blockIdx.x; it < 192; it += gridDim.x) {
        const int l = it / 96, n0 = (it % 96) * 64;
        for (int i = tidx; i < 5 * 1024; i += 512) { const int r = i >> 10, k = i & 1023; const float c = (r < 4) ? PIN(1)[r * 1024 + k] : PIN(3)[k]; ldsf[i] = c / (1.f + __expf(-c)); }
        __syncthreads();
        const int col = tidx & 63, ks = tidx >> 6;
        const float* wp = PIN(4) + (size_t)l * 1024 * 6144 + n0 + col;
        float acc[5] = {0.f, 0.f, 0.f, 0.f, 0.f};
#pragma unroll 8
        for (int k = ks * 128; k < ks * 128 + 128; ++k) {
            const float wv = wp[(size_t)k * 6144];
#pragma unroll
            for (int i = 0; i < 5; ++i) acc[i] += ldsf[i * 1024 + k] * wv;
        }
        float* red = ldsf + 5120;
#pragma unroll
        for (int i = 0; i < 5; ++i) red[(ks * 5 + i) * 64 + col] = acc[i];
        __syncthreads();
        if (tidx < 320) {
            const int i = tidx >> 6; float s = 0.f;
#pragma unroll
            for (int k2 = 0; k2 < 8; ++k2) s += red[(k2 * 5 + i) * 64 + col];
            MOD[(l * 5 + i) * 6144 + n0 + col] = s + PIN(5)[l * 6144 + n0 + col];
        }
        __syncthreads();
    }
    for (int idx = blockIdx.x * 512 + tidx; idx < 4096 * 16; idx += gridDim.x * 512) {
        const int t = idx >> 4, i = idx & 15;
        const float pos = (float)((i < 8) ? (t >> 6) : (t & 63));
        const float freq = powf(10000.f, -(float)(i & 7) / 8.f);
        float s, c; sincosf(pos * freq, &s, &c);
        ROPE[idx * 2] = c; ROPE[idx * 2 + 1] = s;
    }
}

DEVI void mlstm_local_item(const Params& p, int l, int item, const u16* Zp, u16* MQp, u16* MKp, float* GLp, float* CLOCp, float* lf) {
    const int tid = TID();
    const int tb = item % 68, h = (item / 68) & 3, b = item / 272;
    const int rowbase = (tb < 4) ? (RL + b * 256 + tb * 64) : (b * 4096 + (tb - 4) * 64);
    const int seglen = (tb < 4) ? TC : TL, tl0 = (tb < 4) ? tb * 64 : (tb - 4) * 64;
    u16* KT = (u16*)lf;
    u16* VE = KT + 64 * 72;
    float* gl = (float*)(VE + 2 * 80 * 72);
    float* eS = gl + 256;
    float* sc = eS + 128;
    {
        const int c = tid & 63, which = (tid >> 6) & 1, tg = tid >> 7;
        const int ch = which * 256 + h * 64 + c;
        const float w0 = PIN(7)[(l * 3 + 0) * 512 + ch], w1 = PIN(7)[(l * 3 + 1) * 512 + ch], w2 = PIN(7)[(l * 3 + 2) * 512 + ch];
        const int t0 = tg * 16;
        float zv[18];
#pragma unroll
        for (int i = 0; i < 18; ++i) {
            const int tl = tl0 + t0 - 1 + i;
            zv[i] = (tl >= 0 && tl < seglen) ? bf2f(Zp[(size_t)(rowbase + t0 - 1 + i) * NIN + ch]) : 0.f;
        }
#pragma unroll
        for (int i = 0; i < 16; ++i) {
            const int t = t0 + i;
            const float y = w0 * zv[i] + w1 * zv[i + 1] + w2 * zv[i + 2];
            const float sv = y / (1.f + __expf(-y));
            if (which == 0) { MQp[(size_t)(rowbase + t) * 256 + h * 64 + c] = f2bf(sv * 0.125f); }
            else { const u16 kb = f2bf(sv); MKp[(size_t)(rowbase + t) * 256 + h * 64 + c] = kb; KT[c * 72 + t] = kb; }
        }
        for (int i = tid; i < 2 * 15 * 72; i += 512) { const int d = i / (15 * 72), rem = i % (15 * 72); VE[d * 80 * 72 + 65 * 72 + rem] = 0; }
        if (tid < 64) {
            const u16* zr = Zp + (size_t)(rowbase + tid) * NIN + ZC_MG;
            const float* gb = PIN(8) + l * 16;
            const float lif = bf2f(zr[0 + h]) + gb[0 + h], lff = logsig(bf2f(zr[4 + h]) + gb[4 + h]);
            const float lib = bf2f(zr[8 + h]) + gb[8 + h], lfb = logsig(bf2f(zr[12 + h]) + gb[12 + h]);
            gl[tid] = lif; gl[64 + tid] = lff; gl[128 + tid] = lib; gl[192 + tid] = lfb;
            *(float4*)(GLp + (size_t)(rowbase + tid) * 16 + h * 4) = make_float4(lif, lff, lib, lfb);
        }
    }
    __syncthreads();
    if (tid < 128) {
        const int dir = tid >> 6, s = tid & 63, tau = dir ? 63 - s : s;
        float bc = gl[(1 + 2 * dir) * 64 + tau];
#pragma unroll
        for (int o = 1; o < 64; o <<= 1) { const float u = __shfl_up(bc, o); if (s >= o) bc += u; }
        const float bend = __shfl(bc, 63);
        const float we = bend - bc + gl[(2 * dir) * 64 + tau];
        const float ml = wave_max(we);
        const float ev = __expf(we - ml);
        eS[dir * 64 + tau] = ev;
        VE[dir * 80 * 72 + 64 * 72 + tau] = f2bf(ev);
        if (s == 0) { sc[dir * 2] = ml; sc[dir * 2 + 1] = bend; }
    }
    __syncthreads();
    for (int i = tid; i < 4096; i += 512) {
        const int t = i >> 6, cc = i & 63;
        const float vv = bf2f(Zp[(size_t)(rowbase + t) * NIN + ZC_MV + h * 64 + cc]);
        VE[cc * 72 + t] = f2bf(vv * eS[t]); VE[80 * 72 + cc * 72 + t] = f2bf(vv * eS[64 + t]);
    }
    __syncthreads();
    {
        const int lane = tid & 63, w = tid >> 6, g = lane >> 4, li = lane & 15;
        const int dir = w >> 2, kt = w & 3;
        const int c = dir ? ((tb < 4) ? 3 - tb : 71 - tb) : tb;
        const int seq = (dir * 4 + b) * 4 + h;
        float* rec = CLOCp + (size_t)(seq * 68 + c) * CREC;
        f32x4 acc[5];
#pragma unroll
        for (int vt = 0; vt < 5; ++vt) acc[vt] = (f32x4){0.f, 0.f, 0.f, 0.f};
#pragma unroll
        for (int ks = 0; ks < 2; ++ks) {
            const bf16x8 a = *(const bf16x8*)(KT + (kt * 16 + li) * 72 + ks * 32 + g * 8);
#pragma unroll
            for (int vt = 0; vt < 5; ++vt) {
                const bf16x8 bb = *(const bf16x8*)(VE + dir * 80 * 72 + (vt * 16 + li) * 72 + ks * 32 + g * 8);
                acc[vt] = __builtin_amdgcn_mfma_f32_16x16x32_bf16(a, bb, acc[vt], 0, 0, 0);
            }
        }
#pragma unroll
        for (int vt = 0; vt < 4; ++vt) *(float4*)(rec + (vt * 16 + li) * 64 + kt * 16 + 4 * g) = make_float4(acc[vt][0], acc[vt][1], acc[vt][2], acc[vt][3]);
        if (li == 0) *(float4*)(rec + 4096 + kt * 16 + 4 * g) = make_float4(acc[4][0], acc[4][1], acc[4][2], acc[4][3]);
        if (lane == 0 && kt == 0) { rec[4160] = sc[dir * 2]; rec[4161] = sc[dir * 2 + 1]; }
    }
    __syncthreads();
}
DEVI void mlstm_scan_item(int item, float* CLOC, float* lf) {
    const int tid = TID(), seq = item / 9, sl = item % 9;
    float* base = CLOC + (size_t)seq * 68 * CREC;
    float* ao = lf; float* al = lf + 68; float* mp = lf + 136;
    if (tid < 68) { ao[tid] = base[(size_t)tid * CREC + 4160]; al[tid] = base[(size_t)tid * CREC + 4161]; }
    __syncthreads();
    if (tid == 0) {
        float m = 0.f;
        for (int c = 0; c < 68; ++c) {
            const float ml = ao[c], be = al[c];
            const float mn = fmaxf(be + m, ml);
            mp[c] = m; ao[c] = __expf(be + m - mn); al[c] = __expf(ml - mn); m = mn;
        }
    }
    __syncthreads();
    if (sl == 8 && tid < 68) base[(size_t)tid * CREC + 4162] = mp[tid];
    const bool act = (sl < 8) || (tid < 64);
    const int e = (sl < 8) ? sl * 512 + tid : 4096 + tid;
    float st = 0.f;
    if (act) {
#pragma unroll 1
        for (int c0 = 0; c0 < 68; c0 += 17) {
            float v[17];
#pragma unroll
            for (int j = 0; j < 17; ++j) v[j] = base[(size_t)(c0 + j) * CREC + e];
#pragma unroll
            for (int j = 0; j < 17; ++j) { base[(size_t)(c0 + j) * CREC + e] = st; st = ao[c0 + j] * st + al[c0 + j] * v[j]; }
        }
    }
    __syncthreads();
}
DEVI void mlstm_out_item(const Params& p, int l, int b, int h, int tb, const u16* Zp, const u16* MQp, const u16* MKp, const float* GLp, const float* CLOCp, u16* MIXp, float* lf) {
    const int tid = TID(), lane = tid & 63, w = tid >> 6, g = lane >> 4, li = lane & 15;
    const int rowbase = (tb < 4) ? (RL + b * 256 + tb * 64) : (b * 4096 + (tb - 4) * 64);
    u16* Kt = (u16*)lf;
    u16* Qt = Kt + 64 * 72;
    u16* VT = Qt + 64 * 72;
    u16* CP = VT + 64 * 72;
    float* np = (float*)(CP + 2 * 64 * 72);
    float* vec = np + 128;
    float* HB = vec + 512;
    {
        const int row = tid >> 3, seg = tid & 7;
        *(uint4*)(Kt + row * 72 + seg * 8) = *(const uint4*)(MKp + (size_t)(rowbase + row) * 256 + h * 64 + seg * 8);
        *(uint4*)(Qt + row * 72 + seg * 8) = *(const uint4*)(MQp + (size_t)(rowbase + row) * 256 + h * 64 + seg * 8);
        const uint4 vv = *(const uint4*)(Zp + (size_t)(rowbase + row) * NIN + ZC_MV + h * 64 + seg * 8);
        u16* vd = VT + (seg * 8) * 72 + row;
        vd[0] = (u16)(vv.x & 0xffff); vd[72] = (u16)(vv.x >> 16); vd[144] = (u16)(vv.y & 0xffff); vd[216] = (u16)(vv.y >> 16);
        vd[288] = (u16)(vv.z & 0xffff); vd[360] = (u16)(vv.z >> 16); vd[432] = (u16)(vv.w & 0xffff); vd[504] = (u16)(vv.w >> 16);
#pragma unroll
        for (int d = 0; d < 2; ++d) {
            const int c = d ? ((tb < 4) ? 3 - tb : 71 - tb) : tb;
            const float* rec = CLOCp + (size_t)(((d * 4 + b) * 4 + h) * 68 + c) * CREC;
            const float4 c0 = *(const float4*)(rec + row * 64 + seg * 8), c1 = *(const float4*)(rec + row * 64 + seg * 8 + 4);
            *(uint4*)(CP + d * 64 * 72 + row * 72 + seg * 8) = make_uint4(pack2(c0.x, c0.y), pack2(c0.z, c0.w), pack2(c1.x, c1.y), pack2(c1.z, c1.w));
            if (tid < 64) np[d * 64 + tid] = rec[4096 + tid];
        }
        if ((w & 3) == 0) {
            const int d = w >> 2, sq = lane, tau = d ? 63 - sq : sq;
            const int c = d ? ((tb < 4) ? 3 - tb : 71 - tb) : tb;
            const float mprev = CLOCp[(size_t)(((d * 4 + b) * 4 + h) * 68 + c) * CREC + 4162];
            const float4 gv = *(const float4*)(GLp + (size_t)(rowbase + tau) * 16 + h * 4);
            const float li_ = d ? gv.z : gv.x, lfv = d ? gv.w : gv.y;
            float cum = lfv;
#pragma unroll
            for (int o = 1; o < 64; o <<= 1) { const float u = __shfl_up(cum, o); if (sq >= o) cum += u; }
            float pm = li_ - cum;
#pragma unroll
            for (int o = 1; o < 64; o <<= 1) { const float u = __shfl_up(pm, o); if (sq >= o) pm = fmaxf(pm, u); }
            const float mr = cum + fmaxf(mprev, pm);
            float* vd2 = vec + d * 256;
            vd2[tau] = cum; vd2[64 + tau] = li_; vd2[128 + tau] = mr; vd2[192 + tau] = __expf(cum + mprev - mr);
        }
    }
    __syncthreads();
    const int d = w >> 2, jt = w & 3, j = jt * 16 + li;
    const float* vv = vec + d * 256;
    f32x4 o[4];
    {
        bf16x8 qf[2];
#pragma unroll
        for (int ks = 0; ks < 2; ++ks) qf[ks] = *(const bf16x8*)(Qt + j * 72 + ks * 32 + g * 8);
        f32x4 st[4];
#pragma unroll
        for (int s4 = 0; s4 < 4; ++s4) {
            st[s4] = (f32x4){0.f, 0.f, 0.f, 0.f};
#pragma unroll
            for (int ks = 0; ks < 2; ++ks) {
                const bf16x8 a = *(const bf16x8*)(Kt + (s4 * 16 + li) * 72 + ks * 32 + g * 8);
                st[s4] = __builtin_amdgcn_mfma_f32_16x16x32_bf16(a, qf[ks], st[s4], 0, 0, 0);
            }
        }
        const float bcj = vv[j], mrj = vv[128 + j], eij = vv[192 + j];
        float den = 0.f;
#pragma unroll
        for (int s4 = 0; s4 < 4; ++s4)
#pragma unroll
            for (int r = 0; r < 4; ++r) {
                const int sI = s4 * 16 + 4 * g + r;
                const bool ok = d ? (sI >= j) : (sI <= j);
                const float arg = ok ? (bcj - vv[sI] + vv[64 + sI] - mrj) : -INFINITY;
                const float wgt = __expf(arg) * st[s4][r];
                st[s4][r] = wgt; den += wgt;
            }
        den = xrow16_sum(den);
        float nq = 0.f;
#pragma unroll
        for (int ks = 0; ks < 2; ++ks)
#pragma unroll
            for (int i = 0; i < 8; ++i) nq += np[d * 64 + ks * 32 + g * 8 + i] * bf2f((u16)qf[ks][i]);
        nq = xrow16_sum(nq);
        f32x4 it4[4];
#pragma unroll
        for (int vt = 0; vt < 4; ++vt) { o[vt] = (f32x4){0.f, 0.f, 0.f, 0.f}; it4[vt] = (f32x4){0.f, 0.f, 0.f, 0.f}; }
#pragma unroll
        for (int pp = 0; pp < 2; ++pp) {
            union { bf16x8 v; unsigned u[4]; } pf;
            pf.u[0] = pack2(st[2 * pp][0], st[2 * pp][1]); pf.u[1] = pack2(st[2 * pp][2], st[2 * pp][3]);
            pf.u[2] = pack2(st[2 * pp + 1][0], st[2 * pp + 1][1]); pf.u[3] = pack2(st[2 * pp + 1][2], st[2 * pp + 1][3]);
#pragma unroll
            for (int vt = 0; vt < 4; ++vt) {
                union { bf16x8 v; uint2 u[2]; } vf;
                vf.u[0] = *(const uint2*)(VT + (vt * 16 + li) * 72 + 32 * pp + 4 * g);
                vf.u[1] = *(const uint2*)(VT + (vt * 16 + li) * 72 + 32 * pp + 16 + 4 * g);
                o[vt] = __builtin_amdgcn_mfma_f32_16x16x32_bf16(vf.v, pf.v, o[vt], 0, 0, 0);
            }
        }
#pragma unroll
        for (int ks = 0; ks < 2; ++ks)
#pragma unroll
            for (int vt = 0; vt < 4; ++vt) {
                const bf16x8 a = *(const bf16x8*)(CP + d * 64 * 72 + (vt * 16 + li) * 72 + ks * 32 + g * 8);
                it4[vt] = __builtin_amdgcn_mfma_f32_16x16x32_bf16(a, qf[ks], it4[vt], 0, 0, 0);
            }
        const float dn = 1.f / fmaxf(fabsf(den + eij * nq), __expf(-mrj));
#pragma unroll
        for (int vt = 0; vt < 4; ++vt)
#pragma unroll
            for (int r = 0; r < 4; ++r) o[vt][r] = (o[vt][r] + eij * it4[vt][r]) * dn;
    }
    if (d == 1) {
#pragma unroll
        for (int vt = 0; vt < 4; ++vt)
#pragma unroll
            for (int r = 0; r < 4; ++r) HB[j * 65 + vt * 16 + 4 * g + r] = o[vt][r];
    }
    __syncthreads();
    if (d == 0) {
        float sm = 0.f;
#pragma unroll
        for (int vt = 0; vt < 4; ++vt)
#pragma unroll
            for (int r = 0; r < 4; ++r) { o[vt][r] += HB[j * 65 + vt * 16 + 4 * g + r]; sm += o[vt][r]; }
        const float mean = xrow16_sum(sm) * (1.f / 64.f);
        float q2 = 0.f;
#pragma unroll
        for (int vt = 0; vt < 4; ++vt)
#pragma unroll
            for (int r = 0; r < 4; ++r) { o[vt][r] -= mean; q2 += o[vt][r] * o[vt][r]; }
        const float rstd = rsqrtf(xrow16_sum(q2) * (1.f / 64.f) + 1e-6f);
        const u16* zo = Zp + (size_t)(rowbase + j) * NIN + ZC_MO + h * 64;
        const float* nw = PIN(9) + l * 256 + h * 64;
#pragma unroll
        for (int vt = 0; vt < 4; ++vt) {
            const int v0 = vt * 16 + 4 * g;
            const uint2 zz = *(const uint2*)(zo + v0);
            const float4 n4 = *(const float4*)(nw + v0);
            const float a0 = sigm(__uint_as_float(zz.x << 16)) * o[vt][0] * rstd * n4.x, a1 = sigm(__uint_as_float(zz.x & 0xffff0000u)) * o[vt][1] * rstd * n4.y;
            const float a2 = sigm(__uint_as_float(zz.y << 16)) * o[vt][2] * rstd * n4.z, a3 = sigm(__uint_as_float(zz.y & 0xffff0000u)) * o[vt][3] * rstd * n4.w;
            uint2 ov; ov.x = pack2(a0, a1); ov.y = pack2(a2, a3);
            *(uint2*)(MIXp + (size_t)(rowbase + j) * 1024 + h * 64 + v0) = ov;
        }
    }
    __syncthreads();
}

DEVI float2 ld2(const u16* p) { const unsigned u = *(const unsigned*)p; return make_float2(__uint_as_float(u << 16), __uint_as_float(u & 0xffff0000u)); }
DEVI void st2(u16* p, float a, float b) { *(unsigned*)p = pack2(a, b); }
DEVI void prep_rows2(int l, int rbase, int lane, const u16* Zp, u16* RRp, u16* RKp, u16* RVp, u16* KKp, u16* LIp, u16* LAp, u16* Kbp, const float* ROPEp) {
    const float* mu = PIN(10) + l * 1152;
    float2 zs[2][9], zq[2][2], zk[2], xr[2];
    RowInfo ri[2];
#pragma unroll
    for (int q = 0; q < 2; ++q) {
        const int r = rbase + q;
        ri[q] = row_info(r);
        const u16* z0 = Zp + (size_t)r * NIN;
        const bool hp = ri[q].t > 0, hn = ri[q].t < ri[q].seglen - 1;
#pragma unroll
        for (int i = 0; i < 9; ++i) {
            const int c = 2 * lane + 128 * i;
            const float2 zc = ld2(z0 + ZC_RW + c);
            const float2 zp = hp ? ld2(z0 + ZC_RW + c - NIN) : make_float2(0.f, 0.f), zn = hn ? ld2(z0 + ZC_RW + c + NIN) : make_float2(0.f, 0.f);
            const float2 m2 = *(const float2*)(mu + c);
            zs[q][i].x = zc.x + m2.x * (0.5f * (zp.x + zn.x) - zc.x); zs[q][i].y = zc.y + m2.y * (0.5f * (zp.y + zn.y) - zc.y);
        }
        zq[q][0] = ld2(z0 + ZC_MLA + 2 * lane); zq[q][1] = ld2(z0 + ZC_MLA + 2 * lane + 128);
        zk[q] = ld2(z0 + ZC_MLA + 256 + 2 * lane);
        xr[q] = ld2(z0 + ZC_MLA + 384 + 2 * (lane & 15));
    }
#pragma unroll
    for (int q = 0; q < 2; ++q) {
        const int r = rbase + q;
#pragma unroll
        for (int i = 0; i < 9; ++i) {
            const int c = 2 * lane + 128 * i;
            if (i < 2) st2(RRp + (size_t)r * 256 + c, zs[q][i].x, zs[q][i].y);
            else if (i < 4) {
                st2(RKp + (size_t)r * 256 + c - 256, zs[q][i].x, zs[q][i].y);
                const float2 kk2 = *(const float2*)(PIN(16) + l * 256 + c - 256);
                const float k0 = zs[q][i].x * kk2.x, k1 = zs[q][i].y * kk2.y;
                float ss = k0 * k0 + k1 * k1;
                ss += __shfl_xor(ss, 1); ss += __shfl_xor(ss, 2); ss += __shfl_xor(ss, 4); ss += __shfl_xor(ss, 8); ss += __shfl_xor(ss, 16);
                const float rs = rsqrtf(fmaxf(ss, 1e-12f));
                st2(KKp + (size_t)r * 256 + c - 256, k0 * rs, k1 * rs);
            }
            else if (i < 6) st2(RVp + (size_t)r * 256 + c - 512, zs[q][i].x, zs[q][i].y);
            else if (i == 6) st2(LIp + (size_t)r * 384 + c - 768, tanh_(zs[q][i].x), tanh_(zs[q][i].y));
            else if (i == 7) st2(LIp + (size_t)r * 384 + 128 + c - 896, zs[q][i].x, zs[q][i].y);
            else st2(LIp + (size_t)r * 384 + 256 + c - 1024, sigm(zs[q][i].x), sigm(zs[q][i].y));
        }
        float s2 = zq[q][0].x * zq[q][0].x + zq[q][0].y * zq[q][0].y + zq[q][1].x * zq[q][1].x + zq[q][1].y * zq[q][1].y;
        float rs = rsqrtf(wave_sum(s2) * (1.f / 256.f) + 1e-6f);
#pragma unroll
        for (int i = 0; i < 2; ++i) { const float2 nw = *(const float2*)(PIN(21) + l * 256 + 2 * lane + 128 * i); st2(LAp + (size_t)r * 384 + 2 * lane + 128 * i, zq[q][i].x * rs * nw.x, zq[q][i].y * rs * nw.y); }
        rs = rsqrtf(wave_sum(zk[q].x * zk[q].x + zk[q].y * zk[q].y) * (1.f / 128.f) + 1e-6f);
        { const float2 nw = *(const float2*)(PIN(22) + l * 128 + 2 * lane); st2(LAp + (size_t)r * 384 + 256 + 2 * lane, zk[q].x * rs * nw.x, zk[q].y * rs * nw.y); }
        if (lane < 16) {
            float o0 = xr[q].x, o1 = xr[q].y;
            if (!ri[q].isctx) {
                const float cs = ROPEp[(ri[q].t * 16 + lane) * 2], sn = ROPEp[(ri[q].t * 16 + lane) * 2 + 1];
                o0 = xr[q].x * cs - xr[q].y * sn; o1 = xr[q].x * sn + xr[q].y * cs;
            }
            const int idx = ri[q].isctx ? 4096 + ri[q].t : ri[q].t;
            const unsigned ob = pack2(o0, o1);
#pragma unroll
            for (int hh = 0; hh < 8; ++hh) *(unsigned*)(Kbp + ((size_t)(ri[q].b * 8 + hh) * NKEY + idx) * 96 + 64 + 2 * lane) = ob;
        }
    }
}

DEVI int seq_row(int dir, int b, int s) { return (s < 256) ? (RL + b * 256 + (dir ? 255 - s : s)) : (b * 4096 + (dir ? 4095 - (s - 256) : (s - 256))); }
DEVI bf16x8 frag8(const u16* p) { return *(const bf16x8*)p; }
DEVI bf16x8 frag44(const u16* p0, const u16* p1) { union { bf16x8 v; uint2 u[2]; } f; f.u[0] = *(const uint2*)p0; f.u[1] = *(const uint2*)p1; return f.v; }
DEVI bf16x8 pack_acc2(const f32x4& a, const f32x4& b) { union { bf16x8 v; unsigned u[4]; } f; f.u[0] = pack2(a[0], a[1]); f.u[1] = pack2(a[2], a[3]); f.u[2] = pack2(b[0], b[1]); f.u[3] = pack2(b[2], b[3]); return f.v; }
struct R1In { float4 l0, l1; uint4 uk, ub, uq, ur, uv; };
DEVI void rwkv_chunk_prep_load(R1In& I, int ci, int tid, const float* LWp, const u16* KKp, const u16* KKAp, const u16* KVECp, const u16* RRp, const u16* RVp) {
    const int seq = ci / 68, c = ci % 68, dir = seq >> 4, b = (seq >> 2) & 3, h = seq & 3;
    const int i0 = tid >> 3, kc = (tid & 7) * 8;
    const size_t ro = (size_t)seq_row(dir, b, c * 64 + i0) * 256 + h * 64 + kc;
    const size_t dro = (size_t)dir * RT * 256;
    I.l0 = *(const float4*)(LWp + dro + ro); I.l1 = *(const float4*)(LWp + dro + ro + 4);
    I.uk = *(const uint4*)(KKp + ro); I.ub = *(const uint4*)(KKAp + dro + ro); I.uq = *(const uint4*)(KVECp + dro + ro); I.ur = *(const uint4*)(RRp + ro); I.uv = *(const uint4*)(RVp + ro);
}
DEVI void rwkv_chunk_prep_item(int ci, R1In& I, int nci, int tid, const float* LWp, const u16* KKp, const u16* KKAp, const u16* KVECp, const u16* RRp, const u16* RVp,
                               u16* CWp, float* CGLp, u16* CVTp, u16* CMBp, u16* CMQp, u16* CX2p, u16* CBHp, u16* CQHp, unsigned char* lds) {
    const int lane = tid & 63, w = __builtin_amdgcn_readfirstlane(tid >> 6), g = lane >> 4, li = lane & 15;
    float* CWf = (float*)lds;
    u16* X1 = (u16*)(lds + 16384); u16* X2 = X1 + 4608; u16* Y1 = X2 + 4608; u16* Y2 = Y1 + 4608;
    u16* VTs = Y2 + 4608;
    u16* Am = VTs + 4608; u16* Bm = Am + 4608;
    u16* BHs = Bm + 4608; u16* QHs = BHs + 4608;
    float* ADf = (float*)(QHs + 4608);
    u16* TB = (u16*)(ADf + 1024);
    float* segt = (float*)(TB + 1024);
    u16* MBs = (u16*)(segt + 512); u16* MQs = MBs + 4608;
    const size_t cbase = (size_t)ci * 4096;
    const int i0 = tid >> 3, kc = (tid & 7) * 8;
    float lw[8];
    { const float4 a0 = I.l0, a1 = I.l1; lw[0] = a0.x; lw[1] = a0.y; lw[2] = a0.z; lw[3] = a0.w; lw[4] = a1.x; lw[5] = a1.y; lw[6] = a1.z; lw[7] = a1.w; }
    const uint4 uk = I.uk, ub = I.ub, uq = I.uq, ur = I.ur, uv = I.uv;
    *(float4*)(CWf + i0 * 64 + kc) = make_float4(lw[0], lw[1], lw[2], lw[3]); *(float4*)(CWf + i0 * 64 + kc + 4) = make_float4(lw[4], lw[5], lw[6], lw[7]);
    __syncthreads();
    {
        float run = 0.f;
#pragma unroll
        for (int j = 0; j < 8; ++j) { run += CWf[(w * 8 + j) * 64 + lane]; CWf[(w * 8 + j) * 64 + lane] = run; }
        segt[w * 64 + lane] = run;
    }
    __syncthreads();
    {
        float offs = 0.f;
        for (int j = 0; j < w; ++j) offs += segt[j * 64 + lane];
        if (w > 0) {
#pragma unroll
            for (int j = 0; j < 8; ++j) CWf[(w * 8 + j) * 64 + lane] += offs;
        }
    }
    __syncthreads();
    {
        float cw[8], gl8[8];
        { const float4 a0 = *(const float4*)(CWf + i0 * 64 + kc), a1 = *(const float4*)(CWf + i0 * 64 + kc + 4); cw[0] = a0.x; cw[1] = a0.y; cw[2] = a0.z; cw[3] = a0.w; cw[4] = a1.x; cw[5] = a1.y; cw[6] = a1.z; cw[7] = a1.w; }
        { const float4 a0 = *(const float4*)(CWf + 63 * 64 + kc), a1 = *(const float4*)(CWf + 63 * 64 + kc + 4); gl8[0] = a0.x; gl8[1] = a0.y; gl8[2] = a0.z; gl8[3] = a0.w; gl8[4] = a1.x; gl8[5] = a1.y; gl8[6] = a1.z; gl8[7] = a1.w; }
        const unsigned ukk[4] = {uk.x, uk.y, uk.z, uk.w}, ubb[4] = {ub.x, ub.y, ub.z, ub.w}, uqq[4] = {uq.x, uq.y, uq.z, uq.w}, urr[4] = {ur.x, ur.y, ur.z, ur.w}, uvv[4] = {uv.x, uv.y, uv.z, uv.w};
        unsigned o1[4], o2[4], o3[4], o4[4];
#pragma unroll
        for (int j = 0; j < 4; ++j) {
            const float ge0 = __expf(cw[2 * j]), ge1 = __expf(cw[2 * j + 1]);
            const float gp0 = __expf(cw[2 * j] - lw[2 * j]), gp1 = __expf(cw[2 * j + 1] - lw[2 * j + 1]);
            const float gi0 = __expf(-cw[2 * j]), gi1 = __expf(-cw[2 * j + 1]);
            const float k0 = __uint_as_float(ukk[j] << 16), k1 = __uint_as_float(ukk[j] & 0xffff0000u);
            const float b0 = __uint_as_float(ubb[j] << 16), b1 = __uint_as_float(ubb[j] & 0xffff0000u);
            const float q0 = __uint_as_float(uqq[j] << 16), q1 = __uint_as_float(uqq[j] & 0xffff0000u);
            const float r0 = __uint_as_float(urr[j] << 16), r1 = __uint_as_float(urr[j] & 0xffff0000u);
            o1[j] = pack2(k0 * gp0, k1 * gp1); o2[j] = pack2(r0 * ge0, r1 * ge1);
            const float y10 = b0 * gi0, y11 = b1 * gi1, y20 = q0 * gi0, y21 = q1 * gi1;
            o3[j] = pack2(y10, y11); o4[j] = pack2(y20, y21);
            const float gL0 = __expf(gl8[2 * j]), gL1 = __expf(gl8[2 * j + 1]);
            BHs[(kc + 2 * j) * 72 + i0] = f2bf(y10 * gL0); BHs[(kc + 2 * j + 1) * 72 + i0] = f2bf(y11 * gL1);
            QHs[(kc + 2 * j) * 72 + i0] = f2bf(y20 * gL0); QHs[(kc + 2 * j + 1) * 72 + i0] = f2bf(y21 * gL1);
            VTs[(kc + 2 * j) * 72 + i0] = (u16)(uvv[j] & 0xffff); VTs[(kc + 2 * j + 1) * 72 + i0] = (u16)(uvv[j] >> 16);
            if (i0 == 63) { CGLp[(size_t)ci * 64 + kc + 2 * j] = gL0; CGLp[(size_t)ci * 64 + kc + 2 * j + 1] = gL1; }
        }
        *(uint4*)(X1 + i0 * 72 + kc) = make_uint4(o1[0], o1[1], o1[2], o1[3]);
        *(uint4*)(X2 + i0 * 72 + kc) = make_uint4(o2[0], o2[1], o2[2], o2[3]);
        *(uint4*)(Y1 + i0 * 72 + kc) = make_uint4(o3[0], o3[1], o3[2], o3[3]);
        *(uint4*)(Y2 + i0 * 72 + kc) = make_uint4(o4[0], o4[1], o4[2], o4[3]);
        *(uint4*)(CX2p + cbase + i0 * 64 + kc) = make_uint4(o2[0], o2[1], o2[2], o2[3]);
    }
    __syncthreads();
    {
        const int prod = w >> 1;
        const u16* XA = (prod < 2) ? X1 : X2; const u16* YB = (prod & 1) ? Y2 : Y1;
#pragma unroll
        for (int t2 = 0; t2 < 2; ++t2) {
            const int it = 2 * (w & 1) + t2;
            f32x4 acc[4];
#pragma unroll
            for (int st = 0; st < 4; ++st) acc[st] = (f32x4){0.f, 0.f, 0.f, 0.f};
#pragma unroll
            for (int ks = 0; ks < 2; ++ks) {
                const bf16x8 a = frag8(XA + (it * 16 + li) * 72 + ks * 32 + g * 8);
#pragma unroll
                for (int st = 0; st < 4; ++st) acc[st] = __builtin_amdgcn_mfma_f32_16x16x32_bf16(a, frag8(YB + (st * 16 + li) * 72 + ks * 32 + g * 8), acc[st], 0, 0, 0);
            }
#pragma unroll
            for (int st = 0; st < 4; ++st)
#pragma unroll
                for (int r = 0; r < 4; ++r) {
                    const int i = it * 16 + 4 * g + r, sI = st * 16 + li;
                    if (prod < 2) {
                        const float v = (sI < i) ? acc[st][r] : 0.f;
                        ((prod == 0) ? Am : Bm)[i * 72 + sI] = f2bf(v);
                        if (prod == 0 && st == it) ADf[(it * 16 + 4 * g + r) * 16 + li] = v;
                    } else {
                        const float v = (sI <= i) ? acc[st][r] : 0.f;
                        ((prod == 2) ? MBs : MQs)[i * 72 + sI] = f2bf(v);
                    }
                }
        }
    }
    __syncthreads();
    if (nci >= 0) rwkv_chunk_prep_load(I, nci, tid, LWp, KKp, KKAp, KVECp, RRp, RVp);
    if (w == 0) {
        const int bb = lane >> 4, j = lane & 15;
        float t[16];
#pragma unroll
        for (int i = 0; i < 16; ++i) {
            float a = (i == j) ? 1.f : 0.f;
#pragma unroll
            for (int s2 = 0; s2 < i; ++s2) a -= ADf[(bb * 16 + i) * 16 + s2] * t[s2];
            t[i] = a;
            TB[(bb * 16 + i) * 16 + j] = f2bf(a);
        }
    }
    __syncthreads();
    {
        f32x4 rhs[4], R[4];
        if (w < 4) {
#pragma unroll
            for (int it = 0; it < 4; ++it)
#pragma unroll
                for (int r = 0; r < 4; ++r) rhs[it][r] = bf2f(X1[(it * 16 + 4 * g + r) * 72 + w * 16 + li]);
        } else {
#pragma unroll
            for (int it = 0; it < 4; ++it) {
                rhs[it] = (f32x4){0.f, 0.f, 0.f, 0.f};
#pragma unroll
                for (int ks = 0; ks < 2; ++ks)
                    rhs[it] = __builtin_amdgcn_mfma_f32_16x16x32_bf16(frag8(Bm + (it * 16 + li) * 72 + ks * 32 + g * 8), frag8(VTs + ((w - 4) * 16 + li) * 72 + ks * 32 + g * 8), rhs[it], 0, 0, 0);
            }
        }
        const f32x4 z4 = (f32x4){0.f, 0.f, 0.f, 0.f};
#pragma unroll
        for (int bb = 0; bb < 4; ++bb) {
            f32x4 d = rhs[bb];
            if (bb >= 1) {
                f32x4 acc = z4;
                acc = __builtin_amdgcn_mfma_f32_16x16x32_bf16(frag44(Am + (bb * 16 + li) * 72 + 4 * g, Am + (bb * 16 + li) * 72 + 16 + 4 * g), pack_acc2(R[0], (bb >= 2) ? R[1] : z4), acc, 0, 0, 0);
                if (bb == 3) acc = __builtin_amdgcn_mfma_f32_16x16x32_bf16(frag44(Am + (bb * 16 + li) * 72 + 32 + 4 * g, Am + (bb * 16 + li) * 72 + 48 + 4 * g), pack_acc2(R[2], z4), acc, 0, 0, 0);
                d[0] -= acc[0]; d[1] -= acc[1]; d[2] -= acc[2]; d[3] -= acc[3];
            }
            union { bf16x8 v; uint2 u[2]; } tf; tf.u[0] = *(const uint2*)(TB + (bb * 16 + li) * 16 + 4 * g); tf.u[1] = make_uint2(0u, 0u);
            R[bb] = __builtin_amdgcn_mfma_f32_16x16x32_bf16(tf.v, pack_acc2(d, z4), z4, 0, 0, 0);
        }
        if (w < 4) {
#pragma unroll
            for (int bb = 0; bb < 4; ++bb)
#pragma unroll
                for (int r = 0; r < 4; ++r) CWp[cbase + (bb * 16 + 4 * g + r) * 64 + w * 16 + li] = f2bf(R[bb][r]);
        } else {
#pragma unroll
            for (int bb = 0; bb < 4; ++bb) { uint2 o; o.x = pack2(R[bb][0], R[bb][1]); o.y = pack2(R[bb][2], R[bb][3]); *(uint2*)(CVTp + cbase + ((w - 4) * 16 + li) * 64 + bb * 16 + 4 * g) = o; }
        }
    }
    {
        const int row = tid >> 3, sg = (tid & 7) * 8;
        *(uint4*)(CBHp + cbase + row * 64 + sg) = *(const uint4*)(BHs + row * 72 + sg);
        *(uint4*)(CQHp + cbase + row * 64 + sg) = *(const uint4*)(QHs + row * 72 + sg);
        *(uint4*)(CMBp + cbase + row * 64 + sg) = *(const uint4*)(MBs + row * 72 + sg);
        *(uint4*)(CMQp + cbase + row * 64 + sg) = *(const uint4*)(MQs + row * 72 + sg);
    }
    __syncthreads();
}
DEVI void rwkv_chunk_seq_block(int seq, const u16* RVp, const u16* CWp, const float* CGLp, const u16* CVTp, const u16* CMBp, const u16* CMQp, const u16* CX2p, const u16* CBHp, const u16* CQHp,
                               float* OFBp, unsigned char* lds) {
    const int tid = TID(), lane = tid & 63, w = __builtin_amdgcn_readfirstlane(tid >> 6), g = lane >> 4, li = lane & 15;
    const int dir = seq >> 4, b = (seq >> 2) & 3, h = seq & 3;
    u16* Wl = (u16*)lds; u16* X2l = Wl + 4608; u16* MBl = X2l + 4608; u16* MQl = MBl + 4608; u16* BHl = MQl + 4608; u16* QHl = BHl + 4608;
    u16* VTt = QHl + 4608;
    u16* VTl = VTt + 4608;
    u16* Sb = VTl + 4608;
    u16* UT = Sb + 4608;
    float* gLs = (float*)(UT + 4608);
    const int vt = w & 3, hp = w >> 2;
    const int row = tid >> 3, sg = (tid & 7) * 8;
    f32x4 sacc[2];
    sacc[0] = (f32x4){0.f, 0.f, 0.f, 0.f}; sacc[1] = (f32x4){0.f, 0.f, 0.f, 0.f};
    struct Pre { uint4 pW, pX2, pMB, pMQ, pBH, pQH, pVT, pV; float pg; };
    const unsigned vo = (unsigned)(row * 64 + sg) * 2u;
    const int sgn = dir ? -1 : 1;
    const int vrow_off = sgn * row * 512 + sg * 2;
    auto chunk_row0 = [&](int c) -> int { return (c < 4) ? (RL + b * 256 + (dir ? 255 - c * 64 : c * 64)) : (b * 4096 + (dir ? 4095 - (c - 4) * 64 : (c - 4) * 64)); };
    auto gload = [&](Pre& P, int c) {
        const size_t cb = ((size_t)seq * 68 + c) * 8192;
        P.pW = *(const uint4*)((const char*)CWp + cb + vo); P.pX2 = *(const uint4*)((const char*)CX2p + cb + vo); P.pMB = *(const uint4*)((const char*)CMBp + cb + vo); P.pMQ = *(const uint4*)((const char*)CMQp + cb + vo);
        P.pBH = *(const uint4*)((const char*)CBHp + cb + vo); P.pQH = *(const uint4*)((const char*)CQHp + cb + vo); P.pVT = *(const uint4*)((const char*)CVTp + cb + vo);
        P.pV = *(const uint4*)((const char*)RVp + ((size_t)chunk_row0(c) * 256 + h * 64) * 2 + vrow_off);
        P.pg = (tid < 64) ? CGLp[((size_t)seq * 68 + c) * 64 + tid] : 0.f;
    };
    auto body = [&](Pre& P, int c) {
        const uint4 pW = P.pW, pX2 = P.pX2, pMB = P.pMB, pMQ = P.pMQ, pBH = P.pBH, pQH = P.pQH, pVT = P.pVT, pV = P.pV; const float pg = P.pg;
        if (c + 3 < 68) gload(P, c + 3);
        *(uint4*)(Wl + row * 72 + sg) = pW; *(uint4*)(X2l + row * 72 + sg) = pX2; *(uint4*)(MBl + row * 72 + sg) = pMB; *(uint4*)(MQl + row * 72 + sg) = pMQ;
        *(uint4*)(BHl + row * 72 + sg) = pBH; *(uint4*)(QHl + row * 72 + sg) = pQH; *(uint4*)(VTt + row * 72 + sg) = pVT;
        {
            u16* vd = VTl + sg * 72 + row;
            vd[0] = (u16)(pV.x & 0xffff); vd[72] = (u16)(pV.x >> 16); vd[144] = (u16)(pV.y & 0xffff); vd[216] = (u16)(pV.y >> 16);
            vd[288] = (u16)(pV.z & 0xffff); vd[360] = (u16)(pV.z >> 16); vd[432] = (u16)(pV.w & 0xffff); vd[504] = (u16)(pV.w >> 16);
        }
        if (tid < 64) gLs[tid] = pg;
#pragma unroll
        for (int t2 = 0; t2 < 2; ++t2) {
            uint2 o; o.x = pack2(sacc[t2][0], sacc[t2][1]); o.y = pack2(sacc[t2][2], sacc[t2][3]);
            *(uint2*)(Sb + (vt * 16 + li) * 72 + (2 * hp + t2) * 16 + 4 * g) = o;
        }
        lds_barrier();
        {
            bf16x8 wf[2][2], sf0[2];
#pragma unroll
            for (int ks = 0; ks < 2; ++ks) {
                sf0[ks] = frag8(Sb + (vt * 16 + li) * 72 + ks * 32 + g * 8);
#pragma unroll
                for (int t2 = 0; t2 < 2; ++t2) wf[t2][ks] = frag8(Wl + ((2 * hp + t2) * 16 + li) * 72 + ks * 32 + g * 8);
            }
            uint2 vv2[2];
#pragma unroll
            for (int t2 = 0; t2 < 2; ++t2) vv2[t2] = *(const uint2*)(VTt + (vt * 16 + li) * 72 + (2 * hp + t2) * 16 + 4 * g);
            __builtin_amdgcn_sched_barrier(0);
            f32x4 au[2];
            au[0] = (f32x4){0.f, 0.f, 0.f, 0.f}; au[1] = (f32x4){0.f, 0.f, 0.f, 0.f};
#pragma unroll
            for (int ks = 0; ks < 2; ++ks)
#pragma unroll
                for (int t2 = 0; t2 < 2; ++t2) au[t2] = __builtin_amdgcn_mfma_f32_16x16x32_bf16(wf[t2][ks], sf0[ks], au[t2], 0, 0, 0);
#pragma unroll
            for (int t2 = 0; t2 < 2; ++t2) {
                const uint2 vv = vv2[t2];
                const float u0 = -(au[t2][0] + __uint_as_float(vv.x << 16)), u1 = -(au[t2][1] + __uint_as_float(vv.x & 0xffff0000u));
                const float u2 = -(au[t2][2] + __uint_as_float(vv.y << 16)), u3 = -(au[t2][3] + __uint_as_float(vv.y & 0xffff0000u));
                uint2 o; o.x = pack2(u0, u1); o.y = pack2(u2, u3);
                *(uint2*)(UT + (vt * 16 + li) * 72 + (2 * hp + t2) * 16 + 4 * g) = o;
            }
        }
        lds_barrier();
        {
            bf16x8 sf[2], uf[2], vf[2];
#pragma unroll
            for (int ks = 0; ks < 2; ++ks) {
                sf[ks] = frag8(Sb + (vt * 16 + li) * 72 + ks * 32 + g * 8);
                uf[ks] = frag8(UT + (vt * 16 + li) * 72 + ks * 32 + g * 8);
                vf[ks] = frag8(VTl + (vt * 16 + li) * 72 + ks * 32 + g * 8);
            }
            char* ob = (char*)OFBp + (((size_t)dir * RT + chunk_row0(c)) * 256 + h * 64) * 4;
#pragma unroll
            for (int t2 = 0; t2 < 2; ++t2) {
                bf16x8 xf[2], mbf[2], mqf[2], bhf[2], qhf[2];
#pragma unroll
                for (int ks = 0; ks < 2; ++ks) {
                    const int ro2 = ((2 * hp + t2) * 16 + li) * 72 + ks * 32 + g * 8;
                    xf[ks] = frag8(X2l + ro2); mbf[ks] = frag8(MBl + ro2); mqf[ks] = frag8(MQl + ro2); bhf[ks] = frag8(BHl + ro2); qhf[ks] = frag8(QHl + ro2);
                }
                const float4 gl4 = *(const float4*)(gLs + (2 * hp + t2) * 16 + 4 * g);
                f32x4 ao = (f32x4){0.f, 0.f, 0.f, 0.f};
                sacc[t2][0] *= gl4.x; sacc[t2][1] *= gl4.y; sacc[t2][2] *= gl4.z; sacc[t2][3] *= gl4.w;
#pragma unroll
                for (int ks = 0; ks < 2; ++ks) {
                    ao = __builtin_amdgcn_mfma_f32_16x16x32_bf16(xf[ks], sf[ks], ao, 0, 0, 0);
                    sacc[t2] = __builtin_amdgcn_mfma_f32_16x16x32_bf16(bhf[ks], uf[ks], sacc[t2], 0, 0, 0);
                    ao = __builtin_amdgcn_mfma_f32_16x16x32_bf16(mbf[ks], uf[ks], ao, 0, 0, 0);
                    sacc[t2] = __builtin_amdgcn_mfma_f32_16x16x32_bf16(qhf[ks], vf[ks], sacc[t2], 0, 0, 0);
                    ao = __builtin_amdgcn_mfma_f32_16x16x32_bf16(mqf[ks], vf[ks], ao, 0, 0, 0);
                }
                const int oo = sgn * ((2 * hp + t2) * 16 + 4 * g) * 1024 + (vt * 16 + li) * 4;
#pragma unroll
                for (int r = 0; r < 4; ++r) *(float*)(ob + oo + sgn * r * 1024) = ao[r];
            }
        }
        lds_barrier();
    };
    Pre PA, PB, PC;
    gload(PA, 0); gload(PB, 1); gload(PC, 2);
#pragma unroll 1
    for (int c = 0; c < 66; c += 3) { body(PA, c); body(PB, c + 1); body(PC, c + 2); }
    body(PA, 66); body(PB, 67);
}

struct AttnRegs { uint4 k0, k1, v; };
DEVI void attn_item(int b, int h, int q0, int key0, int nkt, int outrow0, const u16* Qp, const u16* Kp, const u16* VTp, u16* MIXp, u16* ls) {
    const int tid = TID(), lane = tid & 63, w = tid >> 6, g = lane >> 4, li = lane & 15;
    const u16* Qh = Qp + (size_t)(b * 8 + h) * NKEY * 96;
    const u16* Kh = Kp + (size_t)(b * 8 + h) * NKEY * 96;
    const u16* Vh = VTp + (size_t)(b * 8 + h) * 64 * NKEY;
    u16* Ks = ls; u16* Vs = ls + 2 * 64 * 104;
    bf16x8 qf[2][3];
#pragma unroll
    for (int qs = 0; qs < 2; ++qs)
#pragma unroll
        for (int ks = 0; ks < 3; ++ks) qf[qs][ks] = *(const bf16x8*)(Qh + (size_t)(q0 + 32 * w + 16 * qs + li) * 96 + ks * 32 + g * 8);
    const int kr0 = tid / 12, kc0 = tid % 12, kr1 = (tid + 512) / 12, kc1 = (tid + 512) % 12;
    const int vr = tid >> 3, vc = tid & 7;
    auto gload = [&](AttnRegs& R, int kt) {
        const int kb = key0 + kt * 64;
        R.k0 = *(const uint4*)(Kh + (size_t)(kb + kr0) * 96 + kc0 * 8);
        if (tid < 256) R.k1 = *(const uint4*)(Kh + (size_t)(kb + kr1) * 96 + kc1 * 8);
        R.v = *(const uint4*)(Vh + (size_t)vr * NKEY + kb + vc * 8);
    };
    auto lstore = [&](const AttnRegs& R, int bsel) {
        *(uint4*)(Ks + bsel * 64 * 104 + kr0 * 104 + kc0 * 8) = R.k0;
        if (tid < 256) *(uint4*)(Ks + bsel * 64 * 104 + kr1 * 104 + kc1 * 8) = R.k1;
        *(uint4*)(Vs + bsel * 64 * 72 + vr * 72 + vc * 8) = R.v;
    };
    f32x4 oacc[2][4];
#pragma unroll
    for (int qs = 0; qs < 2; ++qs)
#pragma unroll
        for (int mt = 0; mt < 4; ++mt) oacc[qs][mt] = (f32x4){0.f, 0.f, 0.f, 0.f};
    float m[2] = {-1e30f, -1e30f}, lsum[2] = {0.f, 0.f};
    auto compute = [&](int bsel) {
        const u16* K0 = Ks + bsel * 64 * 104; const u16* V0 = Vs + bsel * 64 * 72;
        f32x4 st[2][4];
#pragma unroll
        for (int k4 = 0; k4 < 4; ++k4) {
            st[0][k4] = (f32x4){0.f, 0.f, 0.f, 0.f}; st[1][k4] = (f32x4){0.f, 0.f, 0.f, 0.f};
#pragma unroll
            for (int ks = 0; ks < 3; ++ks) {
                const bf16x8 a = *(const bf16x8*)(K0 + (k4 * 16 + li) * 104 + ks * 32 + g * 8);
                st[0][k4] = __builtin_amdgcn_mfma_f32_16x16x32_bf16(a, qf[0][ks], st[0][k4], 0, 0, 0);
                st[1][k4] = __builtin_amdgcn_mfma_f32_16x16x32_bf16(a, qf[1][ks], st[1][k4], 0, 0, 0);
            }
        }
        union PF { bf16x8 v; unsigned u[4]; } pf[2][2];
#pragma unroll
        for (int qs = 0; qs < 2; ++qs) {
            float mx = -1e30f;
#pragma unroll
            for (int k4 = 0; k4 < 4; ++k4)
#pragma unroll
                for (int j = 0; j < 4; ++j) mx = fmaxf(mx, st[qs][k4][j]);
            mx = xrow16_max(mx);
            const float mn = fmaxf(m[qs], mx);
            if (__any(mn > m[qs])) {
                const float alpha = __builtin_amdgcn_exp2f(m[qs] - mn);
                m[qs] = mn;
                lsum[qs] *= alpha;
#pragma unroll
                for (int mt = 0; mt < 4; ++mt) { oacc[qs][mt][0] *= alpha; oacc[qs][mt][1] *= alpha; oacc[qs][mt][2] *= alpha; oacc[qs][mt][3] *= alpha; }
            }
            float ps = 0.f;
#pragma unroll
            for (int k4 = 0; k4 < 4; ++k4)
#pragma unroll
                for (int j = 0; j < 4; ++j) { const float pv = __builtin_amdgcn_exp2f(st[qs][k4][j] - mn); st[qs][k4][j] = pv; ps += pv; }
            lsum[qs] += ps;
#pragma unroll
            for (int pp = 0; pp < 2; ++pp) {
                pf[qs][pp].u[0] = pack2(st[qs][2 * pp][0], st[qs][2 * pp][1]); pf[qs][pp].u[1] = pack2(st[qs][2 * pp][2], st[qs][2 * pp][3]);
                pf[qs][pp].u[2] = pack2(st[qs][2 * pp + 1][0], st[qs][2 * pp + 1][1]); pf[qs][pp].u[3] = pack2(st[qs][2 * pp + 1][2], st[qs][2 * pp + 1][3]);
            }
        }
#pragma unroll
        for (int pp = 0; pp < 2; ++pp)
#pragma unroll
            for (int mt = 0; mt < 4; ++mt) {
                union { bf16x8 v; uint2 u[2]; } vf;
                vf.u[0] = *(const uint2*)(V0 + (mt * 16 + li) * 72 + 32 * pp + 4 * g);
                vf.u[1] = *(const uint2*)(V0 + (mt * 16 + li) * 72 + 32 * pp + 16 + 4 * g);
                oacc[0][mt] = __builtin_amdgcn_mfma_f32_16x16x32_bf16(vf.v, pf[0][pp].v, oacc[0][mt], 0, 0, 0);
                oacc[1][mt] = __builtin_amdgcn_mfma_f32_16x16x32_bf16(vf.v, pf[1][pp].v, oacc[1][mt], 0, 0, 0);
            }
    };
    AttnRegs rA, rB;
    rA.k1 = make_uint4(0, 0, 0, 0); rB.k1 = make_uint4(0, 0, 0, 0);
    gload(rA, 0); lstore(rA, 0); gload(rB, 1);
    lds_barrier();
#pragma unroll 1
    for (int kt = 0; kt < nkt; kt += 2) {
        if (kt + 2 < nkt) gload(rA, kt + 2);
        compute(0);
        lstore(rB, 1);
        lds_barrier();
        if (kt + 3 < nkt) gload(rB, kt + 3);
        compute(1);
        if (kt + 2 < nkt) lstore(rA, 0);
        lds_barrier();
    }
#pragma unroll
    for (int qs = 0; qs < 2; ++qs) {
        float ls2 = lsum[qs];
        ls2 = xrow16_sum(ls2);
        const float inv = 1.f / ls2;
        u16* orow = MIXp + (size_t)(outrow0 + 32 * w + 16 * qs + li) * 1024 + 512 + h * 64;
#pragma unroll
        for (int mt = 0; mt < 4; ++mt) {
            uint2 o; o.x = pack2(oacc[qs][mt][0] * inv, oacc[qs][mt][1] * inv); o.y = pack2(oacc[qs][mt][2] * inv, oacc[qs][mt][3] * inv);
            *(uint2*)(orow + mt * 16 + 4 * g) = o;
        }
    }
}

#define G_HT 8192
DEVI int g_lds_byte(int r, int c) {
    const int st = (r >> 4) * 2 + (c >> 5), rr = r & 15, cc = c & 31, ob = rr * 64 + cc * 2;
    return st * 1024 + (ob ^ (((ob >> 9) & 1) << 5));
}
DEVI void g_stage_rc(int b, int& R, int& C) {
    const int st = b / 1024, sb = b % 1024, swz = sb ^ (((sb >> 9) & 1) << 5);
    R = (st >> 1) * 16 + swz / 64; C = (st & 1) * 32 + (swz % 64) / 2;
}
template <bool AG>
DEVI void gemm256_tile(u16* shm, const u16* Ab, const unsigned (&aoff)[2], const unsigned (&aoff1)[2], unsigned ahs, const u16* Bb, const unsigned (&boff)[2], unsigned bhs, int K,
                       f32x4 (&acc)[2][2][4][2], int tid, int wr, int wc, int fr, int fq) {
    const int wbase = (wr * 4 + wc) * 1024;
    (void)tid;
#define G_SA(b, h) (shm + ((b) * 2 + (h)) * G_HT)
#define G_SB(b, h) (shm + (4 + (b) * 2 + (h)) * G_HT)
#define G_STAGE_A(P, h, kt) do { const char* _b = (const char*)(Ab + (size_t)(kt) * 64 + ((!AG && (h)) ? ahs : 0u)); \
    __builtin_amdgcn_global_load_lds((const unsigned*)(_b + ((AG && (h)) ? aoff1[0] : aoff[0])), (unsigned*)((char*)(P) + wbase), 16, 0, 0); \
    __builtin_amdgcn_global_load_lds((const unsigned*)(_b + ((AG && (h)) ? aoff1[1] : aoff[1])), (unsigned*)((char*)(P) + wbase + 8192), 16, 0, 0); } while (0)
#define G_STAGE_B(P, h, kt) do { const char* _b = (const char*)(Bb + (size_t)(kt) * 64 + ((h) ? bhs : 0u)); \
    __builtin_amdgcn_global_load_lds((const unsigned*)(_b + boff[0]), (unsigned*)((char*)(P) + wbase), 16, 0, 0); \
    __builtin_amdgcn_global_load_lds((const unsigned*)(_b + boff[1]), (unsigned*)((char*)(P) + wbase + 8192), 16, 0, 0); } while (0)
#define G_LDA(dst, b, h) _Pragma("unroll") for (int m = 0; m < 4; ++m) _Pragma("unroll") for (int k = 0; k < 2; ++k) \
    dst[m][k] = *reinterpret_cast<const bf16x8*>((const char*)G_SA(b, h) + g_lds_byte(wr * 64 + m * 16 + fr, k * 32 + fq * 8))
#define G_LDB(dst, b, h) _Pragma("unroll") for (int n = 0; n < 2; ++n) _Pragma("unroll") for (int k = 0; k < 2; ++k) \
    dst[n][k] = *reinterpret_cast<const bf16x8*>((const char*)G_SB(b, h) + g_lds_byte(wc * 32 + n * 16 + fr, k * 32 + fq * 8))
#define G_MMA(ai, bj, At_, Bt_) do { __builtin_amdgcn_s_setprio(1); \
    _Pragma("unroll") for (int m = 0; m < 4; ++m) _Pragma("unroll") for (int n = 0; n < 2; ++n) _Pragma("unroll") for (int k = 0; k < 2; ++k) \
      acc[ai][bj][m][n] = __builtin_amdgcn_mfma_f32_16x16x32_bf16(Bt_[n][k], At_[m][k], acc[ai][bj][m][n], 0, 0, 0); \
    __builtin_amdgcn_s_setprio(0); } while (0)
#define G_WAIT_V(n) asm volatile("s_waitcnt vmcnt(" #n ")" ::: "memory")
#define G_WAIT_L(n) asm volatile("s_waitcnt lgkmcnt(" #n ")" ::: "memory")
#define G_BAR __builtin_amdgcn_s_barrier()
#define G_SCHED __builtin_amdgcn_sched_barrier(0)
#pragma unroll
    for (int ai = 0; ai < 2; ++ai)
#pragma unroll
        for (int bj = 0; bj < 2; ++bj)
#pragma unroll
            for (int m = 0; m < 4; ++m)
#pragma unroll
                for (int n = 0; n < 2; ++n) acc[ai][bj][m][n] = (f32x4){0.f, 0.f, 0.f, 0.f};
    bf16x8 At[4][2], B0[2][2], B1[2][2];
    const int nt = K / 64;
    G_STAGE_B(G_SB(0, 0), 0, 0); G_STAGE_A(G_SA(0, 0), 0, 0);
    G_STAGE_B(G_SB(0, 1), 1, 0); G_STAGE_A(G_SA(0, 1), 1, 0);
    if (wr == 1) G_BAR;
    G_WAIT_V(4); G_BAR;
    G_STAGE_B(G_SB(1, 0), 0, 1); G_STAGE_A(G_SA(1, 0), 0, 1); G_STAGE_B(G_SB(1, 1), 1, 1);
    G_WAIT_V(6); G_BAR;
#pragma unroll 1
    for (int t = 0; t < nt - 2; t += 2) {
        G_LDB(B0, 0, 0); G_SCHED; G_LDA(At, 0, 0); G_STAGE_A(G_SA(1, 1), 1, t + 1);
        G_WAIT_L(8); G_BAR; G_WAIT_L(0); G_MMA(0, 0, At, B0); G_BAR; G_SCHED;
        G_LDB(B1, 0, 1); G_STAGE_B(G_SB(0, 0), 0, t + 2);
        G_BAR; G_WAIT_L(0); G_MMA(0, 1, At, B1); G_BAR;
        G_LDA(At, 0, 1); G_STAGE_A(G_SA(0, 0), 0, t + 2);
        G_BAR; G_WAIT_L(0); G_MMA(1, 0, At, B0); G_BAR; G_SCHED;
        G_STAGE_B(G_SB(0, 1), 1, t + 2);
        G_WAIT_V(6); G_BAR; G_MMA(1, 1, At, B1); G_BAR;
        G_LDB(B0, 1, 0); G_SCHED; G_LDA(At, 1, 0); G_STAGE_A(G_SA(0, 1), 1, t + 2);
        G_WAIT_L(8); G_BAR; G_WAIT_L(0); G_MMA(0, 0, At, B0); G_BAR; G_SCHED;
        G_LDB(B1, 1, 1); G_STAGE_B(G_SB(1, 0), 0, t + 3);
        G_BAR; G_WAIT_L(0); G_MMA(0, 1, At, B1); G_BAR;
        G_LDA(At, 1, 1); G_STAGE_A(G_SA(1, 0), 0, t + 3);
        G_BAR; G_WAIT_L(0); G_MMA(1, 0, At, B0); G_BAR; G_SCHED;
        G_STAGE_B(G_SB(1, 1), 1, t + 3);
        G_WAIT_V(6); G_BAR; G_MMA(1, 1, At, B1); G_BAR;
    }
    {   G_LDB(B0, 0, 0); G_LDA(At, 0, 0); G_STAGE_A(G_SA(1, 1), 1, nt - 1);
        G_BAR; G_WAIT_L(0); G_MMA(0, 0, At, B0); G_BAR;
        G_LDB(B1, 0, 1); G_BAR; G_WAIT_L(0); G_MMA(0, 1, At, B1); G_BAR;
        G_LDA(At, 0, 1); G_WAIT_V(4); G_BAR; G_WAIT_L(0); G_MMA(1, 0, At, B0); G_MMA(1, 1, At, B1); G_BAR; }
    {   G_LDB(B0, 1, 0); G_LDA(At, 1, 0); G_WAIT_V(2); G_BAR; G_WAIT_L(0); G_MMA(0, 0, At, B0); G_BAR;
        G_LDB(B1, 1, 1); G_WAIT_V(0); G_BAR; G_WAIT_L(0); G_MMA(0, 1, At, B1); G_BAR;
        G_LDA(At, 1, 1); G_BAR; G_WAIT_L(0); G_MMA(1, 0, At, B0); G_MMA(1, 1, At, B1); G_BAR; }
    if (wr == 0) G_BAR;
}
#define G_PIECE(i, R, C) int R, C; g_stage_rc(tid * 16 + (i) * 8192, R, C)
#define G_ROW(ai, m) ((ai) * 128 + wr * 64 + (m) * 16 + fr)
#define G_COL(bj, n) ((bj) * 128 + wc * 32 + (n) * 16 + fq * 4)
#define G_IDS const int tid = TID(), wid = __builtin_amdgcn_readfirstlane(tid >> 6), lane = tid & 63, wr = wid >> 2, wc = wid & 3, fr = lane & 15, fq = lane >> 4; (void)lane;

#define CTL  ((unsigned*)(ws + OFF_CTL))
#define MOD  ((float*)(ws + OFF_MOD))
#define ROPE ((float*)(ws + OFF_ROPE))
#define XC   ((float*)(ws + OFF_XC))
#define WTM  ((u16*)(ws + OFF_WTM))
#define H    ((u16*)(ws + OFF_H))
#define MIX  ((u16*)(ws + OFF_H))
#define Z    ((u16*)(ws + S_Z))
#define MQ   ((u16*)(ws + S_MQ))
#define MK   ((u16*)(ws + S_MK))
#define GL   ((float*)(ws + S_GL))
#define CLOC ((float*)(ws + S_CLOC))
#define WD   ((float*)(ws + S_WD))
#define KK   ((u16*)(ws + S_KK))
#define KKA  ((u16*)(ws + S_KKA))
#define KVEC ((u16*)(ws + S_KVEC))
#define RR   ((u16*)(ws + S_RR))
#define RV   ((u16*)(ws + S_RV))
#define RK   ((u16*)(ws + S_RK))
#define GG   ((u16*)(ws + S_G))
#define LI   ((u16*)(ws + S_LI))
#define LA   ((u16*)(ws + S_LA))
#define OFB  ((float*)(ws + S_OF))
#define Qb   ((u16*)(ws + S_Q))
#define Kb   ((u16*)(ws + S_K))
#define VTb  ((u16*)(ws + S_VT))
#define Y    ((float*)(ws + S_Y))
#define YEXP ((u16*)(ws + S_YEXP))
#define WTE  ((u16*)(ws + S_WTE))
#define TOK  ((int*)(ws + S_TOK))
#define GATE ((float*)(ws + S_GATE))
#define SLOT ((int*)(ws + S_SLOT))
#define ACT  ((u16*)(ws + S_ACT))
#define CWg  ((u16*)(ws + S_CW))
#define CGLg ((float*)(ws + S_CGL))
#define CVTg ((u16*)(ws + S_CVT))
#define CMBg ((u16*)(ws + S_CMB))
#define CMQg ((u16*)(ws + S_CMQ))
#define CX2g ((u16*)(ws + S_CX2))
#define CBHg ((u16*)(ws + S_CBH))
#define CQHg ((u16*)(ws + S_CQH))

__global__ void __launch_bounds__(512) mega(Params p) {
    __shared__ __attribute__((aligned(16))) unsigned char lds[LDS_BYTES];
    int tid = threadIdx.x, lane = tid & 63, wv = tid >> 6;
    const int G = gridDim.x, bid = blockIdx.x;
#define REFRESH() do { asm volatile("" : "+v"(tid)); asm volatile("" : "+s"(ws)); lane = tid & 63; wv = tid >> 6; } while (0)
#define STAMP(k) do { if (PROF && bid == 0 && tid == 0) ((unsigned long long*)(CTL + CW_TS))[(k)] = __builtin_amdgcn_s_memrealtime(); } while (0)
    __attribute__((address_space(1))) unsigned char* ws = (__attribute__((address_space(1))) unsigned char*)PIN(39);
    float* lf = (float*)lds; u16* ls = (u16*)lds;
    volatile LAS unsigned* bst = (volatile LAS unsigned*)(lds + LDS_BYTES - 16);
    int* misc = (int*)(lds + LDS_BYTES - 64);
    if (tid < 4) bst[tid] = 0u;
    __syncthreads();
    XcdBarrier bar = xcd_barrier_post(CTL, bst);
    STAMP(0);
#define x_in (PIN(0))
#define ctx_in (PIN(2))
#define OUT ((float*)PIN(38))

    phase_mods(p, MOD, ROPE, lf);
    for (int it = bid; it < N_CONV_MIXER; it += G) conv_mixer_item(p, 0, it, WTM, ls);
    xcd_barrier(bar); STAMP(1);
    for (int r = bid * 8 + wv; r < RT; r += G * 8) {
        const RowInfo ri = row_info(r);
        const float* xr = ri.isctx ? ctx_in + (size_t)(r - RL) * 1024 : x_in + (size_t)r * 1024;
        float4 a[4]; row_load(xr, lane, a); row_ln(a);
        const float* md = MOD + (0 * 5 + ri.mi) * 6144;
        row_affine(a, md + 1024, md, lane, 1.f);
        row_store_bf16(H + (size_t)r * 1024, lane, a);
    }
    xcd_barrier(bar); STAMP(2);

#pragma unroll 1
    for (int l = 0; l < 2; ++l) {
        const bool last = (l == 1);
        const int Rl = last ? RL : RT;
        REFRESH();
        for (int it = bid; it < 68 * 11; it += G) {
            const int m0 = (it / 11) * 256, n0 = (it % 11) * 256;
            G_IDS
            unsigned aoff[2], boff[2];
#pragma unroll
            for (int i = 0; i < 2; ++i) { G_PIECE(i, R, C); aoff[i] = ((unsigned)(m0 + R) * 1024u + C) * 2u; boff[i] = ((unsigned)(n0 + R) * 1024u + C) * 2u; }
            f32x4 acc[2][2][4][2];
            gemm256_tile<false>(ls, H, aoff, aoff, 128u * 1024u, WTM + WTM_WIN, boff, 128u * 1024u, 1024, acc, tid, wr, wc, fr, fq);
#pragma unroll
            for (int ai = 0; ai < 2; ++ai)
#pragma unroll
                for (int bj = 0; bj < 2; ++bj)
#pragma unroll
                    for (int m = 0; m < 4; ++m)
#pragma unroll
                        for (int n = 0; n < 2; ++n) {
                            const int row = m0 + G_ROW(ai, m), col = n0 + G_COL(bj, n);
                            if (col < NIN) { uint2 o; o.x = pack2(acc[ai][bj][m][n][0], acc[ai][bj][m][n][1]); o.y = pack2(acc[ai][bj][m][n][2], acc[ai][bj][m][n][3]); *(uint2*)(Z + (size_t)row * NIN + col) = o; }
                        }
            asm volatile("s_waitcnt vmcnt(0)" ::: "memory");
        }
        xcd_barrier(bar); STAMP(3 + l * 9 + 0);
        REFRESH();
        for (int it = bid; it < 1088 + 1088; it += G) {
            if (it < 1088) mlstm_local_item(p, l, it, Z, MQ, MK, GL, CLOC, lf);
            else prep_rows2(l, (it - 1088) * 16 + wv * 2, lane, Z, RR, RK, RV, KK, LI, LA, Kb, ROPE);
        }
        xcd_barrier(bar); STAMP(3 + l * 9 + 1);
        REFRESH();
        for (int it = bid; it < 288 + 3264; it += G) {
            if (it < 288) { mlstm_scan_item(it, CLOC, lf); continue; }
            int gi = it - 288;
            EPI_IDS
            f32x4 acc[2][4];
            if (gi < 1088) {
                const int kind = gi / 272, t2 = gi % 272, m0 = (t2 >> 1) * 128, n0 = (t2 & 1) * 128, d = kind & 1;
                const u16* A = LI + (size_t)(m0 + (tid >> 2)) * 384 + (kind >> 1) * 128 + d * 64 + (tid & 3) * 8;
                const u16* B = WTM + ((kind >> 1) ? WTM_AUP : WTM_WUP) + (size_t)d * 256 * 64 + (size_t)(n0 + (tid >> 2)) * 64 + (tid & 3) * 8;
                gemm_core<false>(ls, A, B, nullptr, 0, 64, acc);
#pragma unroll
                for (int nt = 0; nt < 2; ++nt)
#pragma unroll
                    for (int mt = 0; mt < 4; ++mt) {
                        const int n = n0 + EPI_N(nt), m = m0 + EPI_M(mt);
                        if (kind < 2) {
                            const float4 w0 = *(const float4*)(PIN(11) + (l * 2 + d) * 256 + n);
                            float4 o;
                            o.x = -0.60653065971263342f * sigm(w0.x + acc[nt][mt][0]); o.y = -0.60653065971263342f * sigm(w0.y + acc[nt][mt][1]);
                            o.z = -0.60653065971263342f * sigm(w0.z + acc[nt][mt][2]); o.w = -0.60653065971263342f * sigm(w0.w + acc[nt][mt][3]);
                            *(float4*)(WD + ((size_t)d * RT + m) * 256 + n) = o;
                        } else {
                            const float4 a0 = *(const float4*)(PIN(13) + (l * 2 + d) * 256 + n);
                            const float4 ka = *(const float4*)(PIN(17) + l * 256 + n);
                            const uint2 kkv = *(const uint2*)(KK + (size_t)m * 256 + n), kv = *(const uint2*)(RK + (size_t)m * 256 + n);
                            const float a_0 = sigm(a0.x + acc[nt][mt][0]), a_1 = sigm(a0.y + acc[nt][mt][1]), a_2 = sigm(a0.z + acc[nt][mt][2]), a_3 = sigm(a0.w + acc[nt][mt][3]);
                            const float kk0 = __uint_as_float(kkv.x << 16), kk1 = __uint_as_float(kkv.x & 0xffff0000u), kk2 = __uint_as_float(kkv.y << 16), kk3 = __uint_as_float(kkv.y & 0xffff0000u);
                            const float k0 = __uint_as_float(kv.x << 16), k1 = __uint_as_float(kv.x & 0xffff0000u), k2 = __uint_as_float(kv.y << 16), k3 = __uint_as_float(kv.y & 0xffff0000u);
                            uint2 o1, o2;
                            o1.x = pack2(kk0 * a_0, kk1 * a_1); o1.y = pack2(kk2 * a_2, kk3 * a_3);
                            o2.x = pack2(k0 * (1.f + (a_0 - 1.f) * ka.x), k1 * (1.f + (a_1 - 1.f) * ka.y)); o2.y = pack2(k2 * (1.f + (a_2 - 1.f) * ka.z), k3 * (1.f + (a_3 - 1.f) * ka.w));
                            *(uint2*)(KKA + ((size_t)d * RT + m) * 256 + n) = o1;
                            *(uint2*)(KVEC + ((size_t)d * RT + m) * 256 + n) = o2;
                        }
                    }
                continue;
            }
            gi -= 1088;
            if (gi < 272) {
                const int m0 = (gi >> 1) * 128, n0 = (gi & 1) * 128;
                gemm_core<false>(ls, LI + (size_t)(m0 + (tid >> 2)) * 384 + 256 + (tid & 3) * 8, WTM + WTM_GUP + (size_t)(n0 + (tid >> 2)) * 128 + (tid & 3) * 8, nullptr, 0, 128, acc);
#pragma unroll
                for (int nt = 0; nt < 2; ++nt)
#pragma unroll
                    for (int mt = 0; mt < 4; ++mt) {
                        const int n = n0 + EPI_N(nt), m = m0 + EPI_M(mt);
                        uint2 o; o.x = pack2(acc[nt][mt][0], acc[nt][mt][1]); o.y = pack2(acc[nt][mt][2], acc[nt][mt][3]);
                        *(uint2*)(GG + (size_t)m * 256 + n) = o;
                    }
                continue;
            }
            gi -= 272;
            if (gi < 816) {
                const int m0 = (gi / 6) * 128, n0 = (gi % 6) * 128;
                gemm_core<false>(ls, LA + (size_t)(m0 + (tid >> 2)) * 384 + (tid & 3) * 8, WTM + WTM_UQ + (size_t)(n0 + (tid >> 2)) * 256 + (tid & 3) * 8, nullptr, 0, 256, acc);
#pragma unroll
                for (int nt = 0; nt < 2; ++nt)
#pragma unroll
                    for (int mt = 0; mt < 4; ++mt) {
                        const int n = n0 + EPI_N(nt), m = m0 + EPI_M(mt);
                        const RowInfo ri = row_info(m);
                        const int hh = n / 96, j = n % 96, idx = ri.isctx ? 4096 + ri.t : ri.t;
                        float x0 = acc[nt][mt][0], x1 = acc[nt][mt][1], x2 = acc[nt][mt][2], x3 = acc[nt][mt][3];
                        if (j >= 64 && !ri.isctx) {
                            const int pi = (j - 64) >> 1;
                            const float4 cs = *(const float4*)(ROPE + (ri.t * 16 + pi) * 2);
                            const float y0 = x0 * cs.x - x1 * cs.y, y1 = x0 * cs.y + x1 * cs.x, y2 = x2 * cs.z - x3 * cs.w, y3 = x2 * cs.w + x3 * cs.z;
                            x0 = y0; x1 = y1; x2 = y2; x3 = y3;
                        }
                        uint2 o; o.x = pack2(x0 * QSCALE, x1 * QSCALE); o.y = pack2(x2 * QSCALE, x3 * QSCALE);
                        *(uint2*)(Qb + ((size_t)(ri.b * 8 + hh) * NKEY + idx) * 96 + j) = o;
                    }
                continue;
            }
            gi -= 816;
            {
                const int m0 = (gi >> 3) * 128, n0 = (gi & 7) * 128;
                gemm_core<false>(ls, LA + (size_t)(m0 + (tid >> 2)) * 384 + 256 + (tid & 3) * 8, WTM + WTM_UKV + (size_t)(n0 + (tid >> 2)) * 128 + (tid & 3) * 8, nullptr, 0, 128, acc);
#pragma unroll
                for (int nt = 0; nt < 2; ++nt)
#pragma unroll
                    for (int mt = 0; mt < 4; ++mt) {
                        const int n = n0 + EPI_N(nt), m = m0 + EPI_M(mt);
                        const RowInfo ri = row_info(m);
                        const int hh = n >> 7, j = n & 127, idx = ri.isctx ? 4096 + ri.t : ri.t;
                        if (j < 64) {
                            uint2 o; o.x = pack2(acc[nt][mt][0], acc[nt][mt][1]); o.y = pack2(acc[nt][mt][2], acc[nt][mt][3]);
                            *(uint2*)(Kb + ((size_t)(ri.b * 8 + hh) * NKEY + idx) * 96 + j) = o;
                        } else {
                            u16* vt = VTb + ((size_t)(ri.b * 8 + hh) * 64 + (j - 64)) * NKEY + idx;
                            vt[0] = f2bf(acc[nt][mt][0]); vt[NKEY] = f2bf(acc[nt][mt][1]); vt[2 * NKEY] = f2bf(acc[nt][mt][2]); vt[3 * NKEY] = f2bf(acc[nt][mt][3]);
                        }
                    }
            }
        }
        xcd_barrier(bar); STAMP(3 + l * 9 + 2);
        REFRESH();
        {
            R1In rin;
            rwkv_chunk_prep_load(rin, bid, tid, WD, KK, KKA, KVEC, RR, RV);
            for (int it = bid; it < 2176; it += G)
                rwkv_chunk_prep_item(it, rin, (it + G < 2176) ? it + G : -1, tid, WD, KK, KKA, KVEC, RR, RV, CWg, CGLg, CVTg, CMBg, CMQg, CX2g, CBHg, CQHg, lds);
        }
        xcd_barrier(bar); STAMP(42 + l);
        REFRESH();
        if (bid < 32) { rwkv_chunk_seq_block(bid, RV, CWg, CGLg, CVTg, CMBg, CMQg, CX2g, CBHg, CQHg, OFB, lds); STAMP(40 + l); }
        {
            const int nAttL = 512, nAttC = last ? 0 : 32, nMl = 1024, nMc = last ? 0 : 64;
            const int total = nAttL + nAttC + nMl + nMc;
            for (;;) {
                __syncthreads();
                if (tid == 0) misc[0] = (int)atomicAdd(&CTL[CW_QUEUE(l)], 1u);
                __syncthreads();
                int it = misc[0];
                if (it >= total) break;
#if PROF
                const unsigned long long tq0 = __builtin_amdgcn_s_memrealtime();
                const int itq = it;
#endif
                if (it < nAttL) { const int b = it >> 7, h = (it >> 4) & 7, qt = it & 15; attn_item(b, h, qt * 256, 0, 68, b * 4096 + qt * 256, Qb, Kb, VTb, MIX, ls); }
                else if (it < nAttL + nAttC) { it -= nAttL; const int b = it >> 3, h = it & 7; attn_item(b, h, 4096, 4096, 4, RL + b * 256, Qb, Kb, VTb, MIX, ls); }
                else if (it < nAttL + nAttC + nMl) { it -= nAttL + nAttC; const int b = it >> 8, h = (it >> 6) & 3, tb = 4 + (it & 63); mlstm_out_item(p, l, b, h, tb, Z, MQ, MK, GL, CLOC, MIX, lf); }
                else { it -= nAttL + nAttC + nMl; const int b = it >> 4, h = (it >> 2) & 3, tb = it & 3; mlstm_out_item(p, l, b, h, tb, Z, MQ, MK, GL, CLOC, MIX, lf); }
#if PROF
                if (bid == G - 1 && tid == 0) { unsigned long long* ts = (unsigned long long*)(CTL + CW_TS); ts[(itq < nAttL + nAttC ? 44 : 48) + l] += __builtin_amdgcn_s_memrealtime() - tq0; }
#endif
            }
        }
        xcd_barrier(bar); STAMP(3 + l * 9 + 3);
        REFRESH();
        {
            const int c0 = lane * 4;
            const float4 rk4 = *(const float4*)(PIN(18) + l * 256 + c0), lw4 = *(const float4*)(PIN(19) + l * 256 + c0), lb4 = *(const float4*)(PIN(20) + l * 256 + c0);
            for (int rb = bid * 16 + wv * 2; rb < Rl; rb += G * 16) {
                float4 of[2], ob[2]; uint2 rr2[2], kf[2], kb2[2], vv2[2], gg2[2];
#pragma unroll
                for (int q = 0; q < 2; ++q) {
                    const size_t ro = (size_t)(rb + q) * 256 + c0;
                    of[q] = *(const float4*)(OFB + ro); ob[q] = *(const float4*)(OFB + (size_t)RT * 256 + ro);
                    rr2[q] = *(const uint2*)(RR + ro); kf[q] = *(const uint2*)(KVEC + ro); kb2[q] = *(const uint2*)(KVEC + (size_t)RT * 256 + ro);
                    vv2[q] = *(const uint2*)(RV + ro); gg2[q] = *(const uint2*)(GG + ro);
                }
#pragma unroll
                for (int q = 0; q < 2; ++q) {
                    float o0 = of[q].x + ob[q].x, o1 = of[q].y + ob[q].y, o2 = of[q].z + ob[q].z, o3 = of[q].w + ob[q].w;
                    const float mean = red16(o0 + o1 + o2 + o3) * (1.f / 64.f);
                    o0 -= mean; o1 -= mean; o2 -= mean; o3 -= mean;
                    const float rstd = rsqrtf(red16(o0 * o0 + o1 * o1 + o2 * o2 + o3 * o3) * (1.f / 64.f) + 64e-5f);
                    const float r0 = __uint_as_float(rr2[q].x << 16), r1 = __uint_as_float(rr2[q].x & 0xffff0000u), r2 = __uint_as_float(rr2[q].y << 16), r3 = __uint_as_float(rr2[q].y & 0xffff0000u);
                    const float k0 = __uint_as_float(kf[q].x << 16) + __uint_as_float(kb2[q].x << 16), k1 = __uint_as_float(kf[q].x & 0xffff0000u) + __uint_as_float(kb2[q].x & 0xffff0000u);
                    const float k2 = __uint_as_float(kf[q].y << 16) + __uint_as_float(kb2[q].y << 16), k3 = __uint_as_float(kf[q].y & 0xffff0000u) + __uint_as_float(kb2[q].y & 0xffff0000u);
                    const float bs = red16(r0 * rk4.x * k0 + r1 * rk4.y * k1 + r2 * rk4.z * k2 + r3 * rk4.w * k3);
                    const float v0 = __uint_as_float(vv2[q].x << 16), v1 = __uint_as_float(vv2[q].x & 0xffff0000u), v2 = __uint_as_float(vv2[q].y << 16), v3 = __uint_as_float(vv2[q].y & 0xffff0000u);
                    const float g0 = __uint_as_float(gg2[q].x << 16), g1 = __uint_as_float(gg2[q].x & 0xffff0000u), g2 = __uint_as_float(gg2[q].y << 16), g3 = __uint_as_float(gg2[q].y & 0xffff0000u);
                    uint2 ov;
                    ov.x = pack2((o0 * rstd * lw4.x + lb4.x + bs * v0) * g0, (o1 * rstd * lw4.y + lb4.y + bs * v1) * g1);
                    ov.y = pack2((o2 * rstd * lw4.z + lb4.z + bs * v2) * g2, (o3 * rstd * lw4.w + lb4.w + bs * v3) * g3);
                    *(uint2*)(MIX + (size_t)(rb + q) * 1024 + 256 + c0) = ov;
                }
            }
        }
        xcd_barrier(bar); STAMP(3 + l * 9 + 4);
        REFRESH();
        for (int it = bid; it < (Rl / 256) * 4; it += G) {
            const int m0 = (it >> 2) * 256, n0 = (it & 3) * 256;
            G_IDS
            unsigned aoff[2], boff[2];
#pragma unroll
            for (int i = 0; i < 2; ++i) { G_PIECE(i, R, C); aoff[i] = ((unsigned)(m0 + R) * 1024u + C) * 2u; boff[i] = ((unsigned)(n0 + R) * 1024u + C) * 2u; }
            f32x4 acc[2][2][4][2];
            gemm256_tile<false>(ls, MIX, aoff, aoff, 128u * 1024u, WTM + WTM_WOUT, boff, 128u * 1024u, 1024, acc, tid, wr, wc, fr, fq);
#pragma unroll
            for (int ai = 0; ai < 2; ++ai)
#pragma unroll
                for (int bj = 0; bj < 2; ++bj)
#pragma unroll
                    for (int m = 0; m < 4; ++m)
#pragma unroll
                        for (int n = 0; n < 2; ++n) {
                            const int row = m0 + G_ROW(ai, m), col = n0 + G_COL(bj, n);
                            *(float4*)(Y + (size_t)row * 1024 + col) = make_float4(acc[ai][bj][m][n][0], acc[ai][bj][m][n][1], acc[ai][bj][m][n][2], acc[ai][bj][m][n][3]);
                        }
            asm volatile("s_waitcnt vmcnt(0)" ::: "memory");
        }
        xcd_barrier(bar); STAMP(3 + l * 9 + 5);
        REFRESH();
        {
            const int rpb = (Rl + G - 1) / G;
            const int r0 = bid * rpb, r1 = min(Rl, r0 + rpb), nrows = max(0, r1 - r0);
            float* H2s = lf;
            float* Pp = lf + 16 * 1028;
            int* lcnt = (int*)(Pp + 8192);
            int* lbase = lcnt + 64;
            int* srec_e = lbase + 64;
            int* srec_p = srec_e + 1024;
            float* srec_g = (float*)(srec_p + 1024);
            if (tid < 64) lcnt[tid] = 0;
            __syncthreads();
            const int g4 = lane >> 4, li = lane & 15;
#pragma unroll 1
            for (int ps = 0; ps * 16 < nrows; ++ps) {
#pragma unroll 1
                for (int i2 = 0; i2 < 2; ++i2) {
                    const int rl = ps * 16 + 2 * wv + i2, r = r0 + rl;
                    float4 a[4];
                    if (rl < nrows) {
                        const RowInfo ri = row_info(r);
                        const float* xr = (l == 0) ? (ri.isctx ? ctx_in + (size_t)(r - RL) * 1024 : x_in + (size_t)r * 1024) : (ri.isctx ? XC + (size_t)(r - RL) * 1024 : OUT + (size_t)r * 1024);
                        float* xw = ri.isctx ? XC + (size_t)(r - RL) * 1024 : OUT + (size_t)r * 1024;
                        const float* md = MOD + (l * 5 + ri.mi) * 6144;
                        float4 y[4]; row_load(xr, lane, a); row_load(Y + (size_t)r * 1024, lane, y);
#pragma unroll
                        for (int i = 0; i < 4; ++i) {
                            const float4 gt = *(const float4*)(md + 2048 + (i * 64 + lane) * 4);
                            a[i].x = ALPHA * a[i].x + gt.x * y[i].x; a[i].y = ALPHA * a[i].y + gt.y * y[i].y; a[i].z = ALPHA * a[i].z + gt.z * y[i].z; a[i].w = ALPHA * a[i].w + gt.w * y[i].w;
                        }
                        row_ln(a); row_affine(a, PIN(26) + l * 1024, PIN(27) + l * 1024, lane, 0.f);
                        row_store_f32(xw, lane, a);
                        row_ln(a); row_affine(a, md + 4096, md + 3072, lane, 1.f);
                        row_store_bf16(H + (size_t)r * 1024, lane, a);
                    } else {
#pragma unroll
                        for (int i = 0; i < 4; ++i) a[i] = make_float4(0.f, 0.f, 0.f, 0.f);
                    }
                    row_store_f32(H2s + (2 * wv + i2) * 1028, lane, a);
                }
                __syncthreads();
                {
                    f32x4 acc[4];
#pragma unroll
                    for (int t = 0; t < 4; ++t) acc[t] = (f32x4){0.f, 0.f, 0.f, 0.f};
                    const float* rw = PIN(28) + (size_t)l * 1024 * 64 + 4 * li;
#pragma unroll 2
                    for (int j = 0; j < 8; ++j) {
                        const int kb = wv * 128 + j * 16 + 4 * g4;
                        const float4 av = *(const float4*)(H2s + li * 1028 + kb);
                        const float4 b0 = *(const float4*)(rw + (size_t)(kb + 0) * 64), b1 = *(const float4*)(rw + (size_t)(kb + 1) * 64);
                        const float4 b2 = *(const float4*)(rw + (size_t)(kb + 2) * 64), b3 = *(const float4*)(rw + (size_t)(kb + 3) * 64);
                        acc[0] = __builtin_amdgcn_mfma_f32_16x16x4f32(av.x, b0.x, acc[0], 0, 0, 0); acc[1] = __builtin_amdgcn_mfma_f32_16x16x4f32(av.x, b0.y, acc[1], 0, 0, 0);
                        acc[2] = __builtin_amdgcn_mfma_f32_16x16x4f32(av.x, b0.z, acc[2], 0, 0, 0); acc[3] = __builtin_amdgcn_mfma_f32_16x16x4f32(av.x, b0.w, acc[3], 0, 0, 0);
                        acc[0] = __builtin_amdgcn_mfma_f32_16x16x4f32(av.y, b1.x, acc[0], 0, 0, 0); acc[1] = __builtin_amdgcn_mfma_f32_16x16x4f32(av.y, b1.y, acc[1], 0, 0, 0);
                        acc[2] = __builtin_amdgcn_mfma_f32_16x16x4f32(av.y, b1.z, acc[2], 0, 0, 0); acc[3] = __builtin_amdgcn_mfma_f32_16x16x4f32(av.y, b1.w, acc[3], 0, 0, 0);
                        acc[0] = __builtin_amdgcn_mfma_f32_16x16x4f32(av.z, b2.x, acc[0], 0, 0, 0); acc[1] = __builtin_amdgcn_mfma_f32_16x16x4f32(av.z, b2.y, acc[1], 0, 0, 0);
                        acc[2] = __builtin_amdgcn_mfma_f32_16x16x4f32(av.z, b2.z, acc[2], 0, 0, 0); acc[3] = __builtin_amdgcn_mfma_f32_16x16x4f32(av.z, b2.w, acc[3], 0, 0, 0);
                        acc[0] = __builtin_amdgcn_mfma_f32_16x16x4f32(av.w, b3.x, acc[0], 0, 0, 0); acc[1] = __builtin_amdgcn_mfma_f32_16x16x4f32(av.w, b3.y, acc[1], 0, 0, 0);
                        acc[2] = __builtin_amdgcn_mfma_f32_16x16x4f32(av.w, b3.z, acc[2], 0, 0, 0); acc[3] = __builtin_amdgcn_mfma_f32_16x16x4f32(av.w, b3.w, acc[3], 0, 0, 0);
                    }
#pragma unroll
                    for (int reg = 0; reg < 4; ++reg)
                        *(float4*)(Pp + (wv * 16 + 4 * g4 + reg) * 64 + 4 * li) = make_float4(acc[0][reg], acc[1][reg], acc[2][reg], acc[3][reg]);
                }
                __syncthreads();
#pragma unroll 1
                for (int i2 = 0; i2 < 2; ++i2) {
                    const int rl = ps * 16 + 2 * wv + i2;
                    if (rl >= nrows) continue;
                    float lg = 0.f;
#pragma unroll
                    for (int w2 = 0; w2 < 8; ++w2) lg += Pp[(w2 * 16 + 2 * wv + i2) * 64 + lane];
                    const float score = sigm(lg), biased = score + PIN(29)[l * 64 + lane];
                    float m1 = biased; m1 = fmaxf(m1, __shfl_xor(m1, 1)); m1 = fmaxf(m1, __shfl_xor(m1, 2)); m1 = fmaxf(m1, __shfl_xor(m1, 4));
                    const unsigned long long eq = __ballot(biased == m1);
                    const int grp = lane >> 3;
                    const int idx1 = __builtin_ctz((unsigned)((eq >> (grp * 8)) & 0xffull));
                    float v2 = ((lane & 7) == idx1) ? -INFINITY : biased;
                    v2 = fmaxf(v2, __shfl_xor(v2, 1)); v2 = fmaxf(v2, __shfl_xor(v2, 2)); v2 = fmaxf(v2, __shfl_xor(v2, 4));
                    const float gs = m1 + v2;
                    int grank = 0;
#pragma unroll
                    for (int j = 0; j < 8; ++j) { const float gj = __shfl(gs, j * 8); grank += (gj > gs || (gj == gs && j < grp)) ? 1 : 0; }
                    const float masked = (grank < 4) ? biased : -INFINITY;
                    int rank = 0;
                    for (int j = 0; j < 64; ++j) { const float vj = __shfl(masked, j); rank += (vj > masked || (vj == masked && j < lane)) ? 1 : 0; }
                    const bool sel = rank < 8;
                    const float ssum = wave_sum(sel ? score : 0.f);
                    if (sel) {
                        const int lp = atomicAdd(&lcnt[lane], 1);
                        srec_e[rl * 8 + rank] = lane; srec_p[rl * 8 + rank] = lp; srec_g[rl * 8 + rank] = 2.5f * score / ssum;
                    }
                }
                __syncthreads();
            }
            if (tid < 64) lbase[tid] = (int)atomicAdd(&CTL[CW_CNT(l) + tid], (unsigned)lcnt[tid]);
            __syncthreads();
            for (int i = tid; i < nrows * 8; i += 512) {
                const int e = srec_e[i], pos = lbase[e] + srec_p[i], r = r0 + (i >> 3);
                TOK[(size_t)e * RT + pos] = r; GATE[(size_t)e * RT + pos] = srec_g[i]; SLOT[(size_t)r * 8 + (i & 7)] = (e << 20) | pos;
            }
            __syncthreads();
            for (int it = bid; it < N_CONV_MOE; it += G) conv_moe_item(l, it, WTE, ls);
        }
        xcd_barrier(bar); STAMP(3 + l * 9 + 6);
        REFRESH();
        {
            int* pre = (int*)(lds + LDS_BYTES - 1024);
            if (tid < 64) pre[136 + tid] = (int)CTL[CW_CNT(l) + tid];
            __syncthreads();
            if (tid == 0) {
                int a = 0, o = 0;
                for (int e = 0; e < 64; ++e) { const int c = pre[136 + e]; pre[e] = a; pre[66 + e] = o; a += (c + 255) >> 8; o += c; }
                pre[64] = a; pre[66 + 64] = SH_SLOT; a += Rl / 256; pre[65] = a;
            }
            __syncthreads();
            const int nmt = pre[65];
            for (int it = bid; it < nmt * 2; it += G) {
                const int im = it >> 1, n0 = (it & 1) * 256;
                int e = 0;
                while (pre[e + 1] <= im) ++e;
                const int mtile = im - pre[e];
                const int cnt = (e < 64) ? pre[136 + e] : Rl;
                const int nvalid = min(256, cnt - mtile * 256);
                const int slot0 = pre[66 + e] + mtile * 256;
                G_IDS
                unsigned aoff[2], aoff1[2], boff[2];
#pragma unroll
                for (int i = 0; i < 2; ++i) {
                    G_PIECE(i, R, C);
                    const int r0 = (R < nvalid) ? R : 0, r1 = (R + 128 < nvalid) ? R + 128 : 0;
                    const int t0 = (e < 64) ? TOK[(size_t)e * RT + mtile * 256 + r0] : mtile * 256 + r0;
                    const int t1 = (e < 64) ? TOK[(size_t)e * RT + mtile * 256 + r1] : mtile * 256 + r1;
                    aoff[i] = ((unsigned)t0 * 1024u + C) * 2u; aoff1[i] = ((unsigned)t1 * 1024u + C) * 2u;
                    boff[i] = ((unsigned)(n0 + R) * 1024u + C) * 2u;
                }
                f32x4 acc[2][2][4][2];
                gemm256_tile<true>(ls, H, aoff, aoff1, 0u, WTE + (size_t)e * WTE_PER, boff, 128u * 1024u, 1024, acc, tid, wr, wc, fr, fq);
#pragma unroll
                for (int ai = 0; ai < 2; ++ai)
#pragma unroll
                    for (int m = 0; m < 4; ++m) {
                        const int row = G_ROW(ai, m);
                        if (row < nvalid) {
#pragma unroll
                            for (int bj = 0; bj < 2; ++bj) {
                                float a0 = acc[ai][bj][m][0][0], a1 = acc[ai][bj][m][0][1], a2 = acc[ai][bj][m][0][2], a3 = acc[ai][bj][m][0][3];
                                a0 = a0 / (1.f + __expf(-a0)) * acc[ai][bj][m][1][0]; a1 = a1 / (1.f + __expf(-a1)) * acc[ai][bj][m][1][1];
                                a2 = a2 / (1.f + __expf(-a2)) * acc[ai][bj][m][1][2]; a3 = a3 / (1.f + __expf(-a3)) * acc[ai][bj][m][1][3];
                                uint2 o; o.x = pack2(a0, a1); o.y = pack2(a2, a3);
                                *(uint2*)(ACT + (size_t)(slot0 + row) * 256 + (n0 >> 1) + bj * 64 + wc * 16 + fq * 4) = o;
                            }
                        }
                    }
                asm volatile("s_waitcnt vmcnt(0)" ::: "memory");
            }
        }
        xcd_barrier(bar);
        REFRESH();
        {
            int* pre = (int*)(lds + LDS_BYTES - 1024);
            if (tid < 64) pre[136 + tid] = (int)CTL[CW_CNT(l) + tid];
            __syncthreads();
            if (tid == 0) {
                int a = 0, o = 0;
                for (int e = 0; e < 64; ++e) { const int c = pre[136 + e]; pre[e] = a; pre[66 + e] = o; a += (c + 255) >> 8; o += c; }
                pre[64] = a; pre[66 + 64] = SH_SLOT; a += Rl / 256; pre[65] = a;
            }
            __syncthreads();
            const int nmt = pre[65];
            for (int it = bid; it < nmt * 4; it += G) {
                const int im = it >> 2, n0 = (it & 3) * 256;
                int e = 0;
                while (pre[e + 1] <= im) ++e;
                const int mtile = im - pre[e];
                const int cnt = (e < 64) ? pre[136 + e] : Rl;
                const int nvalid = min(256, cnt - mtile * 256);
                const int slot0 = pre[66 + e] + mtile * 256;
                G_IDS
                unsigned aoff[2], boff[2];
#pragma unroll
                for (int i = 0; i < 2; ++i) { G_PIECE(i, R, C); aoff[i] = ((unsigned)(slot0 + R) * 256u + C) * 2u; boff[i] = ((unsigned)(n0 + R) * 256u + C) * 2u; }
                f32x4 acc[2][2][4][2];
                gemm256_tile<false>(ls, ACT, aoff, aoff, 128u * 256u, WTE + (size_t)e * WTE_PER + 512 * 1024, boff, 128u * 256u, 256, acc, tid, wr, wc, fr, fq);
#pragma unroll
                for (int ai = 0; ai < 2; ++ai)
#pragma unroll
                    for (int m = 0; m < 4; ++m) {
                        const int row = G_ROW(ai, m);
                        if (row < nvalid) {
                            const float gt = (e < 64) ? GATE[(size_t)e * RT + mtile * 256 + row] : 1.f;
#pragma unroll
                            for (int bj = 0; bj < 2; ++bj)
#pragma unroll
                                for (int n = 0; n < 2; ++n) {
                                    uint2 o; o.x = pack2(acc[ai][bj][m][n][0] * gt, acc[ai][bj][m][n][1] * gt); o.y = pack2(acc[ai][bj][m][n][2] * gt, acc[ai][bj][m][n][3] * gt);
                                    *(uint2*)(YEXP + (size_t)(slot0 + row) * 1024 + n0 + G_COL(bj, n)) = o;
                                }
                        }
                    }
                asm volatile("s_waitcnt vmcnt(0)" ::: "memory");
            }
        }
        xcd_barrier(bar); STAMP(3 + l * 9 + 7);
        REFRESH();
        {
            int* off = (int*)(lds + LDS_BYTES - 1024);
            if (tid < 64) off[64 + tid] = (int)CTL[CW_CNT(l) + tid];
            __syncthreads();
            if (tid == 0) { int o = 0; for (int e = 0; e < 64; ++e) { off[e] = o; o += off[64 + e]; } }
            __syncthreads();
            for (int r = bid * 8 + wv; r < Rl; r += G * 8) {
                const RowInfo ri = row_info(r);
                float* xw = ri.isctx ? XC + (size_t)(r - RL) * 1024 : OUT + (size_t)r * 1024;
                const float* md = MOD + (l * 5 + ri.mi) * 6144;
                int myslot = SH_SLOT + r;
                if (lane < 8) { const int sv = SLOT[(size_t)r * 8 + lane]; myslot = off[sv >> 20] + (sv & 0xfffff); }
                uint4 yv[9][2];
#pragma unroll
                for (int j = 0; j < 9; ++j) {
                    const int slot = __shfl(myslot, j);
                    const u16* yr = YEXP + (size_t)slot * 1024 + lane * 8;
                    yv[j][0] = *(const uint4*)(yr); yv[j][1] = *(const uint4*)(yr + 512);
                }
                float4 a[4];
#pragma unroll
                for (int i = 0; i < 2; ++i) { a[2 * i] = *(const float4*)(xw + lane * 8 + 512 * i); a[2 * i + 1] = *(const float4*)(xw + lane * 8 + 512 * i + 4); }
                float4 f[4];
#pragma unroll
                for (int i = 0; i < 4; ++i) f[i] = make_float4(0.f, 0.f, 0.f, 0.f);
#pragma unroll
                for (int j = 0; j < 9; ++j)
#pragma unroll
                    for (int i = 0; i < 2; ++i) {
                        const uint4 v = yv[j][i];
                        f[2 * i].x += __uint_as_float(v.x << 16); f[2 * i].y += __uint_as_float(v.x & 0xffff0000u); f[2 * i].z += __uint_as_float(v.y << 16); f[2 * i].w += __uint_as_float(v.y & 0xffff0000u);
                        f[2 * i + 1].x += __uint_as_float(v.z << 16); f[2 * i + 1].y += __uint_as_float(v.z & 0xffff0000u); f[2 * i + 1].z += __uint_as_float(v.w << 16); f[2 * i + 1].w += __uint_as_float(v.w & 0xffff0000u);
                    }
#define COLB(i) (lane * 8 + 512 * ((i) >> 1) + 4 * ((i) & 1))
#pragma unroll
                for (int i = 0; i < 4; ++i) {
                    const float4 gt = *(const float4*)(md + 5120 + COLB(i));
                    a[i].x = ALPHA * a[i].x + gt.x * f[i].x; a[i].y = ALPHA * a[i].y + gt.y * f[i].y; a[i].z = ALPHA * a[i].z + gt.z * f[i].z; a[i].w = ALPHA * a[i].w + gt.w * f[i].w;
                }
                row_ln(a);
#pragma unroll
                for (int i = 0; i < 4; ++i) {
                    const float4 m4 = *(const float4*)(PIN(36) + l * 1024 + COLB(i)), d4 = *(const float4*)(PIN(37) + l * 1024 + COLB(i));
                    a[i].x = a[i].x * m4.x + d4.x; a[i].y = a[i].y * m4.y + d4.y; a[i].z = a[i].z * m4.z + d4.z; a[i].w = a[i].w * m4.w + d4.w;
                    *(float4*)(xw + COLB(i)) = a[i];
                }
                if (!last) {
                    const float* md2 = MOD + ((l + 1) * 5 + ri.mi) * 6144;
                    row_ln(a);
                    unsigned ob[8];
#pragma unroll
                    for (int i = 0; i < 4; ++i) {
                        const float4 m4 = *(const float4*)(md2 + 1024 + COLB(i)), d4 = *(const float4*)(md2 + COLB(i));
                        ob[2 * i] = pack2(a[i].x * (m4.x + 1.f) + d4.x, a[i].y * (m4.y + 1.f) + d4.y); ob[2 * i + 1] = pack2(a[i].z * (m4.z + 1.f) + d4.z, a[i].w * (m4.w + 1.f) + d4.w);
                    }
                    *(uint4*)(H + (size_t)r * 1024 + lane * 8) = make_uint4(ob[0], ob[1], ob[2], ob[3]);
                    *(uint4*)(H + (size_t)r * 1024 + lane * 8 + 512) = make_uint4(ob[4], ob[5], ob[6], ob[7]);
                }
            }
            if (!last) for (int it = bid; it < N_CONV_MIXER; it += G) conv_mixer_item(p, l + 1, it, WTM, ls);
            __syncthreads();
        }
        if (!last || PROF) { xcd_barrier(bar); STAMP(3 + l * 9 + 8); }
    }
#if PROF
    {
        xcd_barrier(bar);
        REFRESH();
        const unsigned long long* ts = (const unsigned long long*)(CTL + CW_TS);
        const float tot = (float)(ts[20] - ts[0]);
        auto frac = [&](int q) -> float {
            if (q == 0) return (float)(ts[1] - ts[0]) / tot;
            if (q == 1) return (float)(ts[2] - ts[1]) / tot;
            if (q == 11) return (float)((ts[40] - ts[42]) + (ts[41] - ts[43])) / tot;
            if (q == 14) return (float)((ts[42] - ts[5]) + (ts[43] - ts[14])) / tot;
            if (q == 12) return (float)(ts[44] + ts[45]) / tot;
            if (q == 13) return (float)(ts[48] + ts[49]) / tot;
            const int j = q - 2;
            return (float)((ts[3 + j] - ts[2 + j]) + (ts[12 + j] - ts[11 + j])) / tot;
        };
        const float f1 = frac(PROF_A), f2 = frac(PROF_B);
        const float sc = 1.f + sqrtf(3e-4f * f1);
        for (int r = bid * 8 + wv; r < RL; r += G * 8) {
            float4 a[4]; row_load(OUT + (size_t)r * 1024, lane, a);
#pragma unroll
            for (int i = 0; i < 4; ++i) { a[i].x *= sc; a[i].y *= sc; a[i].z *= sc; a[i].w *= sc; }
            if (r == 0 && lane == 0) a[0].x += 1.f + 8.9f * f2;
            row_store_f32(OUT + (size_t)r * 1024, lane, a);
        }
    }
#endif
}

extern "C" void kernel_launch(void* const* d_in, const int* in_sizes, int n_in, void* d_out, int out_size, void* d_ws, size_t ws_size, hipStream_t stream) {
    static int grid = 0;
    if (grid == 0) {
        int dev = 0, cus = 0, per_cu = 0;
        hipGetDevice(&dev);
        hipDeviceGetAttribute(&cus, hipDeviceAttributeMultiprocessorCount, dev);
        hipOccupancyMaxActiveBlocksPerMultiprocessor(&per_cu, (const void*)mega, 512, 0);
        (void)hipGetLastError();
        grid = (per_cu >= 1 && cus >= 256) ? 256 : -1;
        if (n_in != 38 || ws_size < WS_NEED) grid = -1;
        if (grid < 0) fprintf(stderr, "kernel_launch: cannot run (cus %d, per_cu %d, n_in %d, ws %zu need %zu)\n", cus, per_cu, n_in, ws_size, (size_t)WS_NEED);
    }
    if (grid < 0) return;
    hipMemsetAsync((char*)d_ws + OFF_CTL, 0, 65536, stream);
    Params p{};
    for (int i = 0; i < 38; ++i) p.in[i] = (const float*)d_in[i];
    p.out = (float*)d_out; p.ws = (unsigned char*)d_ws;
    hipLaunchKernelGGL(mega, dim3(grid), dim3(512), 0, stream, p);
}
```
